# Optimizing an MI355X kernel written in HIP

```python
import jax, jax.numpy as jnp
from jax import lax
import numpy as np

D_MODEL = 1024
BATCH = 16
SEQ = 256
DEPTH = 4
DEC_BATCH = 2
DEC_SEQ = 2048
PAST_LEN = 256

GRID_W = 64
HEAD_DIM = 64
NA_HEADS = 4
NA_ROWS = 8
NA_COLS = 16
GQ_HEADS = 4
GQ_KV_HEADS = 2
WIN_HEADS = 4
WIN_KV_HEADS = 2
WINDOW = 128
BLOCK = 128
MLA_HEADS = 4
MLA_NOPE = 64
MLA_ROPE = 32
MLA_V = 64
MLA_KV_LORA = 128
MLA_QK = MLA_NOPE + MLA_ROPE
N_BRANCH = 4
BRANCH_W = 256
D_FF = 2816
CONV_W = 3
ROPE_THETA = 10000.0
EPS = 1e-6
NEG_INF = -1e30

IN_SIZES = (NA_HEADS * HEAD_DIM, NA_HEADS * HEAD_DIM, NA_HEADS * HEAD_DIM,
            GQ_HEADS * HEAD_DIM, GQ_KV_HEADS * HEAD_DIM, GQ_KV_HEADS * HEAD_DIM,
            WIN_HEADS * HEAD_DIM, WIN_KV_HEADS * HEAD_DIM, WIN_KV_HEADS * HEAD_DIM,
            MLA_HEADS * MLA_QK, MLA_KV_LORA, MLA_ROPE,
            N_BRANCH * D_MODEL)
IN_SPLITS = tuple(sum(IN_SIZES[:i + 1]) for i in range(len(IN_SIZES) - 1))
IN_COLS = sum(IN_SIZES)

kernel_name = 'hybrid_diffusion_prefix_step'


def _rmsnorm(x, g):
    xf = x.astype(jnp.float32)
    y = xf * lax.rsqrt(jnp.mean(xf * xf, axis=-1, keepdims=True) + EPS)
    return (y * g.astype(jnp.float32)).astype(x.dtype)


def _axial_cos_sin(T, dim):
    half = dim // 2
    inv = ROPE_THETA ** (-jnp.arange(0, half, 2, dtype=jnp.float32) / half)
    t = jnp.arange(T, dtype=jnp.int32)
    row = (t // GRID_W).astype(jnp.float32)[:, None] * inv[None, :]
    col = (t % GRID_W).astype(jnp.float32)[:, None] * inv[None, :]
    ang = jnp.concatenate([row, row, col, col], axis=-1)
    return jnp.cos(ang), jnp.sin(ang)


def _rotate_half(v):
    a, b = jnp.split(v, 2, axis=-1)
    return jnp.concatenate([-b, a], axis=-1)


def _apply_axial_rope(x, cos, sin):
    half = x.shape[-1] // 2
    xf = x.astype(jnp.float32)
    rot = jnp.concatenate([_rotate_half(xf[..., :half]), _rotate_half(xf[..., half:])], axis=-1)
    return (xf * cos[:, None, :] + rot * sin[:, None, :]).astype(x.dtype)


def _rope_tail(x, cos, sin):
    return jnp.concatenate([x[..., :MLA_NOPE], _apply_axial_rope(x[..., MLA_NOPE:], cos, sin)], axis=-1)


def _softmax_with_sink(s, sink):
    m = jnp.maximum(jnp.max(s, axis=-1, keepdims=True), sink)
    e = jnp.exp(s - m)
    return e / (jnp.sum(e, axis=-1, keepdims=True) + jnp.exp(sink - m))


def _dense_attn(q, k, v, sink=None):
    B, Tq, Hq, dk = q.shape
    Hkv = k.shape[2]
    g = Hq // Hkv
    qg = q.reshape(B, Tq, Hkv, g, dk)
    s = jnp.einsum('bqhgd,bkhd->bhgqk', qg, k, preferred_element_type=jnp.float32) * (dk ** -0.5)
    if sink is None:
        p = jax.nn.softmax(s, axis=-1)
    else:
        p = _softmax_with_sink(s, sink.astype(jnp.float32).reshape(1, Hkv, g, 1, 1))
    o = jnp.einsum('bhgqk,bkhd->bqhgd', p.astype(v.dtype), v)
    return o.reshape(B, Tq, Hq * v.shape[-1])


def _blocked_global_attn(q, k, v, k_ctx, v_ctx):
    B, T, Hq, dk = q.shape
    Hkv = k.shape[2]
    g = Hq // Hkv
    dv = v.shape[-1]
    k_all = jnp.concatenate([k_ctx, k], axis=1)
    v_all = jnp.concatenate([v_ctx, v], axis=1)
    qb = q.reshape(B, T // BLOCK, BLOCK, Hkv, g, dk).transpose(1, 0, 2, 3, 4, 5)

    def one_block(qblk):
        s = jnp.einsum('bqhgd,bkhd->bhgqk', qblk, k_all, preferred_element_type=jnp.float32) * (dk ** -0.5)
        p = jax.nn.softmax(s, axis=-1).astype(v_all.dtype)
        return jnp.einsum('bhgqk,bkhd->bqhgd', p, v_all)

    o = lax.map(one_block, qb)
    return o.transpose(1, 0, 2, 3, 4, 5).reshape(B, T, Hq * dv)


def _window_attn(q, k, v, k_ctx, v_ctx, sink):
    B, T, Hq, d = q.shape
    Hkv = k.shape[2]
    g = Hq // Hkv
    nb = T // BLOCK
    pad = ((0, 0), (BLOCK, BLOCK), (0, 0), (0, 0))
    kp = jnp.pad(k, pad)
    vp = jnp.pad(v, pad)

    def band(xp):
        return jnp.concatenate(
            [xp[:, i * BLOCK: i * BLOCK + T].reshape(B, nb, BLOCK, Hkv, xp.shape[-1]) for i in range(3)], axis=2)

    kb = band(kp)
    vb = band(vp)
    qb = q.reshape(B, nb, BLOCK, Hkv, g, d)
    scale = d ** -0.5
    s_loc = jnp.einsum('bnqhgd,bnkhd->bhgnqk', qb, kb, preferred_element_type=jnp.float32) * scale
    qpos = jnp.arange(T).reshape(nb, BLOCK)[:, :, None]
    kpos = (jnp.arange(nb)[:, None] * BLOCK - BLOCK + jnp.arange(3 * BLOCK)[None, :])[:, None, :]
    ok = (jnp.abs(qpos - kpos) <= WINDOW) & (kpos >= 0) & (kpos < T)
    s_loc = jnp.where(ok, s_loc, NEG_INF)
    s_ctx = jnp.einsum('bnqhgd,blhd->bhgnql', qb, k_ctx, preferred_element_type=jnp.float32) * scale
    L = k_ctx.shape[1]
    sk = sink.astype(jnp.float32).reshape(1, Hkv, g, 1, 1, 1)
    p = _softmax_with_sink(jnp.concatenate([s_ctx, s_loc], axis=-1), sk).astype(v.dtype)
    o = (jnp.einsum('bhgnql,blhd->bnqhgd', p[..., :L], v_ctx)
         + jnp.einsum('bhgnqk,bnkhd->bnqhgd', p[..., L:], vb))
    return o.reshape(B, T, Hq * d)


def _neighbourhood_attn(q, k, v, k_ctx, v_ctx, rpb):
    B, T, H, d = q.shape
    rows = T // GRID_W
    wr = min(NA_ROWS, rows)
    n_keys = wr * GRID_W
    r_idx = jnp.arange(rows)
    c_idx = jnp.arange(GRID_W)
    r0 = jnp.clip(r_idx - wr // 2, 0, rows - wr)
    c0 = jnp.clip(c_idx - NA_COLS // 2, 0, GRID_W - NA_COLS)
    key_rows = r0[:, None] + jnp.arange(wr)[None, :]
    kg = k.reshape(B, rows, GRID_W, H, d)[:, key_rows].reshape(B, rows, n_keys, H, d)
    vg = v.reshape(B, rows, GRID_W, H, d)[:, key_rows].reshape(B, rows, n_keys, H, d)
    qg = q.reshape(B, rows, GRID_W, H, d)
    key_r = jnp.repeat(key_rows, GRID_W, axis=1)
    key_c = jnp.broadcast_to(c_idx[None, :], (wr, GRID_W)).reshape(n_keys)
    col_ok = (key_c[None, :] >= c0[:, None]) & (key_c[None, :] < c0[:, None] + NA_COLS)
    dr = key_r - r_idx[:, None] + (NA_ROWS - 1)
    dc = jnp.clip(key_c[None, :] - c_idx[:, None], 1 - NA_COLS, NA_COLS - 1) + (NA_COLS - 1)
    bias = rpb[:, dr[:, None, :], dc[None, :, :]].astype(jnp.float32)
    scale = d ** -0.5
    s_loc = jnp.einsum('brqhd,brkhd->bhrqk', qg, kg, preferred_element_type=jnp.float32) * scale + bias[None]
    s_loc = jnp.where(col_ok[None, None, None], s_loc, NEG_INF)
    s_ctx = jnp.einsum('brqhd,blhd->bhrql', qg, k_ctx, preferred_element_type=jnp.float32) * scale
    L = k_ctx.shape[1]
    p = jax.nn.softmax(jnp.concatenate([s_ctx, s_loc], axis=-1), axis=-1).astype(v.dtype)
    o = (jnp.einsum('bhrql,blhd->brqhd', p[..., :L], v_ctx)
         + jnp.einsum('bhrqk,brkhd->brqhd', p[..., L:], vg))
    return o.reshape(B, T, H * d)


def _adaln(cond, lp):
    m = jax.nn.silu(cond) @ lp['w_ada'] + lp['b_ada']
    return jnp.split(m, 6, axis=-1)


def _mixer_inputs(h, lp):
    B, T = h.shape[0], h.shape[1]
    (qa, ka, va, qb, kb, vb, qc, kc, vc, qd, ckv, kpe, gates) = jnp.split(h @ lp['w_in'], IN_SPLITS, axis=-1)

    def heads(t, n, dd):
        return t.reshape(B, T, n, dd)

    return {
        'qa': _rmsnorm(heads(qa, NA_HEADS, HEAD_DIM), lp['qn_a']),
        'ka': _rmsnorm(heads(ka, NA_HEADS, HEAD_DIM), lp['kn_a']),
        'va': heads(va, NA_HEADS, HEAD_DIM),
        'qb': _rmsnorm(heads(qb, GQ_HEADS, HEAD_DIM), lp['qn_b']),
        'kb': _rmsnorm(heads(kb, GQ_KV_HEADS, HEAD_DIM), lp['kn_b']),
        'vb': heads(vb, GQ_KV_HEADS, HEAD_DIM),
        'qc': _rmsnorm(heads(qc, WIN_HEADS, HEAD_DIM), lp['qn_c']),
        'kc': _rmsnorm(heads(kc, WIN_KV_HEADS, HEAD_DIM), lp['kn_c']),
        'vc': heads(vc, WIN_KV_HEADS, HEAD_DIM),
        'qd': _rmsnorm(heads(qd, MLA_HEADS, MLA_QK), lp['qn_d']),
        'ckv': _rmsnorm(ckv, lp['kvn_d']),
        'kpe': kpe,
        'gates': jax.nn.sigmoid(gates.astype(jnp.float32)).astype(h.dtype).reshape(B, T, N_BRANCH, D_MODEL),
    }


def _mla_kv(ckv, kpe, w_ukv, kn):
    B, T = ckv.shape[0], ckv.shape[1]
    kv = (ckv @ w_ukv).reshape(B, T, MLA_HEADS, MLA_NOPE + MLA_V)
    k_nope, v = kv[..., :MLA_NOPE], kv[..., MLA_NOPE:]
    kpe_h = jnp.broadcast_to(kpe[:, :, None, :], (B, T, MLA_HEADS, MLA_ROPE))
    k = _rmsnorm(jnp.concatenate([k_nope, kpe_h], axis=-1), kn)
    return k, v


def _merge(branches, gates, lp):
    br = jnp.stack(branches, axis=2)
    proj = jnp.einsum('btnc,ncd->btnd', br, lp['w_branch'])
    return jnp.sum(gates * proj, axis=2) @ lp['w_out']


def _conv_ffn(h, lp):
    u = h @ lp['w_up']
    T = u.shape[1]
    half = CONV_W // 2
    up = jnp.pad(u, ((0, 0), (half, half), (0, 0)))
    acc = lp['conv_b'] + up[:, 0:T] * lp['conv_w'][0]
    for j in range(1, CONV_W):
        acc = acc + up[:, j:j + T] * lp['conv_w'][j]
    a, g = jnp.split(acc, 2, axis=-1)
    return (jax.nn.silu(g) * a) @ lp['w_down']


def _context_layer(x, c_ctx, lp):
    sh1, sc1, g1, sh2, sc2, g2 = _adaln(c_ctx[None, None, :], lp)
    h = _rmsnorm(x, lp['norm1']) * (1 + sc1) + sh1
    m = _mixer_inputs(h, lp)
    kd, vd = _mla_kv(m['ckv'], m['kpe'], lp['w_ukv'], lp['kn_d'])
    oa = _dense_attn(m['qa'], m['ka'], m['va'])
    ob = _dense_attn(m['qb'], m['kb'], m['vb'])
    oc = _dense_attn(m['qc'], m['kc'], m['vc'], lp['sink_c'])
    od = _dense_attn(m['qd'], kd, vd)
    x = x + g1 * _merge((oa, ob, oc, od), m['gates'], lp)
    h2 = _rmsnorm(x, lp['norm2']) * (1 + sc2) + sh2
    x = x + g2 * _conv_ffn(h2, lp)
    ctx = (m['ka'], m['va'], m['kb'], m['vb'], m['kc'], m['vc'], m['ckv'], m['kpe'])
    return x, ctx


def _latent_layer(x, c, ctx, lp, cos64, sin64, cos32, sin32):
    cka, cva, ckb, cvb, ckc, cvc, cckv, ckpe = ctx
    sh1, sc1, g1, sh2, sc2, g2 = _adaln(c[:, None, :], lp)
    h = _rmsnorm(x, lp['norm1']) * (1 + sc1) + sh1
    m = _mixer_inputs(h, lp)
    oa = _neighbourhood_attn(m['qa'], m['ka'], m['va'], cka, cva, lp['rpb_a'])
    ob = _blocked_global_attn(_apply_axial_rope(m['qb'], cos64, sin64),
                              _apply_axial_rope(m['kb'], cos64, sin64), m['vb'], ckb, cvb)
    oc = _window_attn(_apply_axial_rope(m['qc'], cos64, sin64),
                      _apply_axial_rope(m['kc'], cos64, sin64), m['vc'], ckc, cvc, lp['sink_c'])
    kd, vd = _mla_kv(m['ckv'], m['kpe'], lp['w_ukv'], lp['kn_d'])
    kd_ctx, vd_ctx = _mla_kv(cckv, ckpe, lp['w_ukv'], lp['kn_d'])
    od = _blocked_global_attn(_rope_tail(m['qd'], cos32, sin32), _rope_tail(kd, cos32, sin32),
                              vd, kd_ctx, vd_ctx)
    x = x + g1 * _merge((oa, ob, oc, od), m['gates'], lp)
    h2 = _rmsnorm(x, lp['norm2']) * (1 + sc2) + sh2
    return x + g2 * _conv_ffn(h2, lp)


def setup_inputs(seed: int = 0) -> dict:
    key = jax.random.key(seed)
    keys = list(jax.random.split(key, 48))
    f32 = jnp.float32

    def nrm(shape, scale=1.0):
        return jax.random.normal(keys.pop(), shape, f32) * scale

    def gain(shape):
        return 1.0 + 0.05 * jax.random.normal(keys.pop(), shape, f32)

    L = PAST_LEN
    return {
        'x_prompt': nrm((BATCH, SEQ, D_MODEL)),
        'x_sample': nrm((DEC_BATCH, DEC_SEQ, D_MODEL)),
        'cache_nat_k': nrm((DEC_BATCH, DEPTH, L, NA_HEADS, HEAD_DIM)),
        'cache_nat_v': nrm((DEC_BATCH, DEPTH, L, NA_HEADS, HEAD_DIM)),
        'cache_gqa_k': nrm((DEC_BATCH, DEPTH, L, GQ_KV_HEADS, HEAD_DIM)),
        'cache_gqa_v': nrm((DEC_BATCH, DEPTH, L, GQ_KV_HEADS, HEAD_DIM)),
        'cache_win_k': nrm((DEC_BATCH, DEPTH, L, WIN_KV_HEADS, HEAD_DIM)),
        'cache_win_v': nrm((DEC_BATCH, DEPTH, L, WIN_KV_HEADS, HEAD_DIM)),
        'cache_mla_ckv': nrm((DEC_BATCH, DEPTH, L, MLA_KV_LORA)),
        'cache_mla_kpe': nrm((DEC_BATCH, DEPTH, L, MLA_ROPE)),
        'c': nrm((DEC_BATCH, D_MODEL)),
        'c_ctx': nrm((D_MODEL,)),
        'w_ada': nrm((DEPTH, D_MODEL, 6 * D_MODEL), 0.5 * D_MODEL ** -0.5),
        'b_ada': nrm((DEPTH, 6 * D_MODEL), 0.1),
        'norm1': gain((DEPTH, D_MODEL)),
        'norm2': gain((DEPTH, D_MODEL)),
        'w_in': nrm((DEPTH, D_MODEL, IN_COLS), D_MODEL ** -0.5),
        'qn_a': gain((DEPTH, HEAD_DIM)),
        'kn_a': gain((DEPTH, HEAD_DIM)),
        'rpb_a': nrm((DEPTH, NA_HEADS, 2 * NA_ROWS - 1, 2 * NA_COLS - 1), 0.1),
        'qn_b': gain((DEPTH, HEAD_DIM)),
        'kn_b': gain((DEPTH, HEAD_DIM)),
        'qn_c': gain((DEPTH, HEAD_DIM)),
        'kn_c': gain((DEPTH, HEAD_DIM)),
        'sink_c': nrm((DEPTH, WIN_HEADS), 0.5),
        'qn_d': gain((DEPTH, MLA_QK)),
        'kn_d': gain((DEPTH, MLA_QK)),
        'kvn_d': gain((DEPTH, MLA_KV_LORA)),
        'w_ukv': nrm((DEPTH, MLA_KV_LORA, MLA_HEADS * (MLA_NOPE + MLA_V)), MLA_KV_LORA ** -0.5),
        'w_branch': nrm((DEPTH, N_BRANCH, BRANCH_W, D_MODEL), BRANCH_W ** -0.5),
        'w_out': nrm((DEPTH, D_MODEL, D_MODEL), D_MODEL ** -0.5),
        'w_up': nrm((DEPTH, D_MODEL, 2 * D_FF), D_MODEL ** -0.5),
        'conv_w': nrm((DEPTH, CONV_W, 2 * D_FF), CONV_W ** -0.5),
        'conv_b': nrm((DEPTH, 2 * D_FF), 0.02),
        'w_down': nrm((DEPTH, D_FF, D_MODEL), D_FF ** -0.5),
    }


def reference(x_prompt, x_sample, cache_nat_k, cache_nat_v, cache_gqa_k, cache_gqa_v,
              cache_win_k, cache_win_v, cache_mla_ckv, cache_mla_kpe, c, c_ctx,
              w_ada, b_ada, norm1, norm2, w_in, qn_a, kn_a, rpb_a, qn_b, kn_b, qn_c, kn_c,
              sink_c, qn_d, kn_d, kvn_d, w_ukv, w_branch, w_out, w_up, conv_w, conv_b, w_down):
    T = x_sample.shape[1]
    cos64, sin64 = _axial_cos_sin(T, HEAD_DIM)
    cos32, sin32 = _axial_cos_sin(T, MLA_ROPE)
    xp = x_prompt
    xs = x_sample
    new = [[] for _ in range(8)]
    for l in range(DEPTH):
        lp = {
            'w_ada': w_ada[l], 'b_ada': b_ada[l], 'norm1': norm1[l], 'norm2': norm2[l],
            'w_in': w_in[l], 'qn_a': qn_a[l], 'kn_a': kn_a[l], 'rpb_a': rpb_a[l],
            'qn_b': qn_b[l], 'kn_b': kn_b[l], 'qn_c': qn_c[l], 'kn_c': kn_c[l],
            'sink_c': sink_c[l], 'qn_d': qn_d[l], 'kn_d': kn_d[l], 'kvn_d': kvn_d[l],
            'w_ukv': w_ukv[l], 'w_branch': w_branch[l], 'w_out': w_out[l],
            'w_up': w_up[l], 'conv_w': conv_w[l], 'conv_b': conv_b[l], 'w_down': w_down[l],
        }
        xp, ctx_new = _context_layer(xp, c_ctx, lp)
        for lst, t in zip(new, ctx_new):
            lst.append(t)
        ctx_cached = (cache_nat_k[:, l], cache_nat_v[:, l], cache_gqa_k[:, l], cache_gqa_v[:, l],
                      cache_win_k[:, l], cache_win_v[:, l], cache_mla_ckv[:, l], cache_mla_kpe[:, l])
        xs = _latent_layer(xs, c, ctx_cached, lp, cos64, sin64, cos32, sin32)
    nat_k = jnp.stack(new[0], axis=1)
    nat_v = jnp.stack(new[1], axis=1)
    gqa_k = jnp.stack(new[2], axis=1)
    gqa_v = jnp.stack(new[3], axis=1)
    win_k = jnp.stack(new[4], axis=1)
    win_v = jnp.stack(new[5], axis=1)
    mla_ckv = jnp.stack(new[6], axis=1)
    mla_kpe = jnp.stack(new[7], axis=1)
    return (xp, xs, nat_k, nat_v, gqa_k, gqa_v, win_k, win_v, mla_ckv, mla_kpe)
```

```cpp
#include <hip/hip_runtime.h>
#include <stdint.h>
#include <stdio.h>

#ifndef SINGLE_LAUNCH
#define SINGLE_LAUNCH 1
#endif

typedef unsigned short u16;
typedef short bf16x8 __attribute__((ext_vector_type(8)));
typedef short s16x4 __attribute__((ext_vector_type(4)));
typedef float f32x16 __attribute__((ext_vector_type(16)));
typedef float f32x4 __attribute__((ext_vector_type(4)));
typedef unsigned u32x4 __attribute__((ext_vector_type(4)));
typedef unsigned u32x2 __attribute__((ext_vector_type(2)));
typedef __bf16 bf2_t __attribute__((ext_vector_type(2)));
typedef float f2_t __attribute__((ext_vector_type(2)));
typedef short v4i16_t __attribute__((ext_vector_type(4)));

#define DI __device__ __forceinline__
#define MFMA(a, b, c) __builtin_amdgcn_mfma_f32_32x32x16_bf16((a), (b), (c), 0, 0, 0)
#define LAS __attribute__((address_space(3)))

DI unsigned pk2(float a, float b) { f2_t v = {a, b}; return __builtin_bit_cast(unsigned, __builtin_convertvector(v, bf2_t)); }
DI float bf_lo(unsigned u) { return __uint_as_float(u << 16); }
DI float bf_hi(unsigned u) { return __uint_as_float(u & 0xffff0000u); }
DI int crow(int r, int hi) { return (r & 3) + 8 * (r >> 2) + 4 * hi; }
DI float ex2(float x) { return __builtin_amdgcn_exp2f(x); }
constexpr float LOG2E_ = 1.4426950408889634f;
DI float sigmoidf_(float x) { return __builtin_amdgcn_rcpf(1.f + ex2(-LOG2E_ * x)); }
DI float siluf_(float x) { return x * __builtin_amdgcn_rcpf(1.f + ex2(-LOG2E_ * x)); }
DI int tidx() { int t = threadIdx.x; asm volatile("" : "+v"(t)); return t; }

constexpr int NTOK = 8192, NCTX = 4096, DM = 1024, INC = 6432, PROJC = 2336, DFF = 2816, UPC = 5632, DEPTH = 4;
constexpr float EPS = 1e-6f;
constexpr float LOG2E = 1.4426950408889634f;
constexpr float QS64 = 0.125f * LOG2E;
constexpr float QS96 = 0.10206207261596575f * LOG2E;
constexpr int NPHASE = 1 + 8 * DEPTH;
constexpr int SMEM_BYTES = 73728;
constexpr int INP = 6656;

constexpr size_t O_X = 0, O_NATK = 8388608, O_NATV = 12582912, O_GQAK = 16777216, O_GQAV = 18874368,
                 O_WINK = 20971520, O_WINV = 23068672, O_CKV = 25165824, O_KPE = 27262976;

struct Params {
  const float *x_prompt, *x_sample, *c_nat_k, *c_nat_v, *c_gqa_k, *c_gqa_v, *c_win_k, *c_win_v, *c_mla_ckv, *c_mla_kpe;
  const float *c, *c_ctx, *w_ada, *b_ada, *norm1, *norm2, *w_in, *qn_a, *kn_a, *rpb_a, *qn_b, *kn_b, *qn_c, *kn_c, *sink_c;
  const float *qn_d, *kn_d, *kvn_d, *w_ukv, *w_branch, *w_out, *w_up, *conv_w, *conv_b, *w_down;
  float* out;
  unsigned* ctrl;
  float* mod;
  float* tabs;
  float* proj;
  u16* gates;
  u16 *QA, *KA, *VA, *QB, *KB, *VB, *QC, *KC, *VC, *QD, *KD, *VD;
  u16* ckvn;
  u16* br;
  u16* merged;
  u16* u;
  u16* act;
  u16 *CKA, *CVA, *CKB, *CVB, *CKC, *CVC, *CKD, *CVD;
  u16 *Wt_in, *Wt_up, *Wt_down, *Wt_out, *Wt_br, *Wt_ukv;
  float* ub;
  float* kpe;
  u16* cckv;
  u16* h;
};

#define XB_TMO      128
#define XB_XCNT(j)  (256  + 64 * (j))
#define XB_XSUB(j)  (1280 + 64 * (j))
#define XB_XGEN(j)  (2304 + 64 * (j))
#define XB_TOP      3328
#define XB_TOPGEN   3392
#define XCD_BAR_WORDS 3456
#define CTRL_QUEUE(l) (3520 + 64 * (l))
#define CTRL_WORDS 4096
#define XB_SPIN_CAP (1u << 22)
DI unsigned xb_ld(unsigned* p) { return __hip_atomic_load(p, __ATOMIC_RELAXED, __HIP_MEMORY_SCOPE_AGENT); }
DI unsigned xb_add(unsigned* p, unsigned v) { return __hip_atomic_fetch_add(p, v, __ATOMIC_RELAXED, __HIP_MEMORY_SCOPE_AGENT); }
DI unsigned xb_xcc_id() { return (unsigned)__builtin_amdgcn_s_getreg((3 << 11) | 20) & 0xFu; }
#define XB_SPIN(cond, bar) do { unsigned _sp = 0; while (cond) { __builtin_amdgcn_s_sleep(1); \
    if ((++_sp & 255u) == 0u) { if (xb_ld(&(bar)[XB_TMO])) break; if (_sp > XB_SPIN_CAP) { atomicAdd(&(bar)[XB_TMO], 1u); break; } } } } while (0)
struct XcdBarrier { unsigned* bar; unsigned x; volatile LAS unsigned* st; };
DI XcdBarrier xcd_barrier_post(unsigned* bar, volatile LAS unsigned* st) {
  XcdBarrier b; b.bar = bar; b.x = xb_xcc_id(); b.st = st;
  if (threadIdx.x == 0) (void)xb_add(&bar[XB_XCNT(b.x)], 1u);
  return b;
}
DI void xcd_barrier_complete(unsigned* bar, unsigned x, unsigned& nloc, unsigned& nx) {
  const unsigned G = gridDim.x * gridDim.y * gridDim.z;
  unsigned sum, cnt, mine, sp = 0u;
  for (;;) {
    sum = 0u; cnt = 0u; mine = 0u;
#pragma unroll
    for (unsigned j = 0; j < 16; ++j) { const unsigned c = xb_ld(&bar[XB_XCNT(j)]); sum += c; cnt += (c > 0u) ? 1u : 0u; mine = (j == x) ? c : mine; }
    if (sum == G) break;
    __builtin_amdgcn_s_sleep(1);
    if ((++sp & 255u) == 0u) { if (xb_ld(&bar[XB_TMO])) break; if (sp > XB_SPIN_CAP) { atomicAdd(&bar[XB_TMO], 1u); break; } }
  }
  nloc = mine > 0u ? mine : 1u; nx = cnt > 0u ? cnt : 1u;
}
DI void xcd_barrier(const XcdBarrier& b) {
  asm volatile("s_waitcnt vmcnt(0)" ::: "memory");
  __syncthreads();
  if (threadIdx.x == 0) {
    unsigned* bar = b.bar;
    __builtin_amdgcn_s_waitcnt(0);
    unsigned nloc = b.st[0], nx = b.st[1];
    if (nloc == 0u) { xcd_barrier_complete(bar, b.x, nloc, nx); b.st[0] = nloc; b.st[1] = nx; }
    const unsigned old = xb_add(&bar[XB_XSUB(b.x)], 1u);
    const unsigned gen = old / nloc;
    if (old + 1u == (gen + 1u) * nloc) {
      __builtin_amdgcn_fence(__ATOMIC_RELEASE, "agent");
      asm volatile("s_waitcnt vmcnt(0)" ::: "memory");
      const unsigned og = xb_add(&bar[XB_TOP], 1u);
      const unsigned tg = og / nx;
      if (og + 1u == (tg + 1u) * nx) xb_add(&bar[XB_TOPGEN], 1u);
      else XB_SPIN(xb_ld(&bar[XB_TOPGEN]) == tg, bar);
      __builtin_amdgcn_fence(__ATOMIC_ACQUIRE, "agent");
      xb_add(&bar[XB_XGEN(b.x)], 1u);
      asm volatile("s_waitcnt vmcnt(0)" ::: "memory");
    } else {
      XB_SPIN(xb_ld(&bar[XB_XGEN(b.x)]) == gen, bar);
      __builtin_amdgcn_fence(__ATOMIC_ACQUIRE, "agent");
      asm volatile("s_waitcnt vmcnt(0)" ::: "memory");
    }
  }
  __syncthreads();
}

constexpr int LDS_LD = 72;
constexpr int STG = 128 * LDS_LD;

struct G2Regs { u32x4 r0a[4], r0b[4], r1a[4], r1b[4]; };
struct G2Ptrs { const u16* ap; const u16* bp; size_t a32, b32, bextra; };
DI G2Ptrs g2_ptrs(const u16* A, int lda, const u16* Bt, int ldb, size_t bextra) {
  const int tid = tidx();
  const int lr = tid >> 3, lc = (tid & 7) * 8;
  G2Ptrs P; P.ap = A + (size_t)lr * lda + lc; P.bp = Bt + (size_t)lr * ldb + lc; P.a32 = (size_t)32 * lda; P.b32 = (size_t)32 * ldb; P.bextra = bextra;
  return P;
}
#define G2_ISSUE(RA, RB, kt_) do { const u16* a_ = P.ap + (size_t)(kt_) * 64; const u16* b_ = P.bp + (size_t)(kt_) * 64; \
    _Pragma("unroll") for (int i = 0; i < 4; ++i) RA[i] = *(const u32x4*)(a_ + i * P.a32); \
    _Pragma("unroll") for (int i = 0; i < 4; ++i) RB[i] = *(const u32x4*)(b_ + i * P.b32 + (i >= 2 ? P.bextra : (size_t)0)); } while (0)
DI void g2_prefetch(G2Regs& R, const G2Ptrs& P) {
  G2_ISSUE(R.r0a, R.r0b, 0);
  G2_ISSUE(R.r1a, R.r1b, 1);
}
DI void g2_main(f32x16 (&acc)[2][2], G2Regs& R, const G2Ptrs& P, int K, char* smem) {
  u16* S = (u16*)smem;
  const int tid = tidx(), lane = tid & 63, wave = tid >> 6, r32 = lane & 31, hi = lane >> 5;
  const int wm = wave >> 1, wn = wave & 1;
  const int lr = tid >> 3, lc = (tid & 7) * 8;
#define G2_STORE(RA, RB, buf_) do { u16* As_ = S + (buf_) * 2 * STG + lr * LDS_LD + lc; u16* Bs_ = As_ + STG; \
    _Pragma("unroll") for (int i = 0; i < 4; ++i) *(u32x4*)(As_ + i * 32 * LDS_LD) = RA[i]; \
    _Pragma("unroll") for (int i = 0; i < 4; ++i) *(u32x4*)(Bs_ + i * 32 * LDS_LD) = RB[i]; } while (0)
  const u16* afr = S + (wm * 64 + r32) * LDS_LD + hi * 8;
  const u16* bfr = S + STG + (wn * 64 + r32) * LDS_LD + hi * 8;
#define G2_FRAG(buf_, ks_, A0, A1, B0, B1) do { const u16* a_ = afr + (buf_) * 2 * STG + (ks_) * 16; const u16* b_ = bfr + (buf_) * 2 * STG + (ks_) * 16; \
    A0 = *(const bf16x8*)(a_); A1 = *(const bf16x8*)(a_ + 32 * LDS_LD); B0 = *(const bf16x8*)(b_); B1 = *(const bf16x8*)(b_ + 32 * LDS_LD); } while (0)
#define G2_MMA(A0, A1, B0, B1) do { acc[0][0] = MFMA(B0, A0, acc[0][0]); acc[0][1] = MFMA(B1, A0, acc[0][1]); \
    acc[1][0] = MFMA(B0, A1, acc[1][0]); acc[1][1] = MFMA(B1, A1, acc[1][1]); } while (0)
#define G2_COMPUTE(buf_) do { bf16x8 a0, a1, b0, b1, c0, c1, d0, d1; \
    G2_FRAG(buf_, 0, a0, a1, b0, b1); G2_FRAG(buf_, 1, c0, c1, d0, d1); __builtin_amdgcn_s_setprio(1); G2_MMA(a0, a1, b0, b1); \
    G2_FRAG(buf_, 2, a0, a1, b0, b1); G2_MMA(c0, c1, d0, d1); \
    G2_FRAG(buf_, 3, c0, c1, d0, d1); G2_MMA(a0, a1, b0, b1); G2_MMA(c0, c1, d0, d1); __builtin_amdgcn_s_setprio(0); } while (0)
  const int KT = K >> 6;
  __syncthreads();
  G2_STORE(R.r0a, R.r0b, 0);
  G2_STORE(R.r1a, R.r1b, 1);
  if (KT > 2) G2_ISSUE(R.r0a, R.r0b, 2);
  if (KT > 3) G2_ISSUE(R.r1a, R.r1b, 3);
  __syncthreads();
  for (int kt = 0; kt < KT; kt += 2) {
    G2_COMPUTE(0);
    __syncthreads();
    if (kt + 2 < KT) {
      G2_STORE(R.r0a, R.r0b, 0);
      if (kt + 4 < KT) G2_ISSUE(R.r0a, R.r0b, kt + 4);
    }
    G2_COMPUTE(1);
    __syncthreads();
    if (kt + 3 < KT) {
      G2_STORE(R.r1a, R.r1b, 1);
      if (kt + 5 < KT) G2_ISSUE(R.r1a, R.r1b, kt + 5);
    }
  }
#undef G2_STORE
#undef G2_FRAG
#undef G2_MMA
#undef G2_COMPUTE
}
DI void gemm2(f32x16 (&acc)[2][2], const u16* A, int lda, const u16* Bt, int ldb, int K, char* smem, size_t bextra = 0) {
  G2Regs R; const G2Ptrs P = g2_ptrs(A, lda, Bt, ldb, bextra);
  g2_prefetch(R, P);
  g2_main(acc, R, P, K, smem);
}

DI void gemm2s(f32x16 (&acc)[2][2], const u16* A, int lda, const u16* Bt, int ldb, int K, char* smem) {
  u16* S = (u16*)smem;
  const int tid = tidx(), lane = tid & 63, wave = tid >> 6, r32 = lane & 31, hi = lane >> 5;
  const int wm = wave >> 1, wn = wave & 1;
  const int lr = tid >> 3, lc = (tid & 7) * 8;
  const u16* ap = A + (size_t)lr * lda + lc;
  const u16* bp = Bt + (size_t)lr * ldb + lc;
  const size_t a32 = (size_t)32 * lda, b32 = (size_t)32 * ldb;
  u32x4 ra[4], rb[4];
  const int KT = K >> 6;
  __syncthreads();
#pragma unroll
  for (int i = 0; i < 4; ++i) { ra[i] = *(const u32x4*)(ap + i * a32); rb[i] = *(const u32x4*)(bp + i * b32); }
#pragma unroll 1
  for (int kt = 0; kt < KT; ++kt) {
    const int cur = kt & 1;
    {
      u16* As_ = S + cur * 2 * STG + lr * LDS_LD + lc; u16* Bs_ = As_ + STG;
#pragma unroll
      for (int i = 0; i < 4; ++i) { *(u32x4*)(As_ + i * 32 * LDS_LD) = ra[i]; *(u32x4*)(Bs_ + i * 32 * LDS_LD) = rb[i]; }
    }
    __syncthreads();
    if (kt + 1 < KT) {
      const u16* a_ = ap + (size_t)(kt + 1) * 64; const u16* b_ = bp + (size_t)(kt + 1) * 64;
#pragma unroll
      for (int i = 0; i < 4; ++i) { ra[i] = *(const u32x4*)(a_ + i * a32); rb[i] = *(const u32x4*)(b_ + i * b32); }
    }
    const u16* As_ = S + cur * 2 * STG; const u16* Bs_ = As_ + STG;
#pragma unroll
    for (int ks = 0; ks < 4; ++ks) {
      const bf16x8 a0 = *(const bf16x8*)(As_ + (wm * 64 + r32) * LDS_LD + ks * 16 + hi * 8);
      const bf16x8 a1 = *(const bf16x8*)(As_ + (wm * 64 + 32 + r32) * LDS_LD + ks * 16 + hi * 8);
      const bf16x8 b0 = *(const bf16x8*)(Bs_ + (wn * 64 + r32) * LDS_LD + ks * 16 + hi * 8);
      const bf16x8 b1 = *(const bf16x8*)(Bs_ + (wn * 64 + 32 + r32) * LDS_LD + ks * 16 + hi * 8);
      acc[0][0] = MFMA(b0, a0, acc[0][0]); acc[0][1] = MFMA(b1, a0, acc[0][1]);
      acc[1][0] = MFMA(b0, a1, acc[1][0]); acc[1][1] = MFMA(b1, a1, acc[1][1]);
    }
  }
  __syncthreads();
}

DI void zero_acc(f32x16 (&acc)[2][2]) {
#pragma unroll
  for (int i = 0; i < 2; ++i)
#pragma unroll
    for (int j = 0; j < 2; ++j)
#pragma unroll
      for (int r = 0; r < 16; ++r) acc[i][j][r] = 0.f;
}

DI void epi_residual(f32x16 (&acc)[2][2], float* x, const float* xin  , const float* gvec, int m0, int n0) {
  const int tid = tidx(), lane = tid & 63, wave = tid >> 6, r32 = lane & 31, hi = lane >> 5;
  const int wm = wave >> 1, wn = wave & 1;
#pragma unroll
  for (int i = 0; i < 2; ++i)
#pragma unroll
    for (int j = 0; j < 2; ++j) {
      const int col = n0 + wn * 64 + j * 32 + 4 * hi;
      float* px = x + (size_t)(m0 + wm * 64 + i * 32 + r32) * DM + col;
      const float* pin = xin + (size_t)(wm * 64 + i * 32 + r32) * DM + col;
#pragma unroll
      for (int g = 0; g < 4; ++g) {
        const f32x4 gv = *(const f32x4*)(gvec + col + 8 * g);
        f32x4 xv = *(const f32x4*)(pin + 8 * g);
#pragma unroll
        for (int e = 0; e < 4; ++e) xv[e] += gv[e] * acc[i][j][4 * g + e];
        *(f32x4*)(px + 8 * g) = xv;
      }
    }
}

DI void phase_norm(const Params& p, int l, int which) {
  const int tid = tidx(), lane = tid & 63, wave = tid >> 6;
  const float* nrm = (which ? p.norm2 : p.norm1) + l * DM;
  const int stride = gridDim.x * 4;
  f32x4 nv[4];
#pragma unroll
  for (int i = 0; i < 4; ++i) nv[i] = *(const f32x4*)(nrm + i * 256 + lane * 4);
  for (int row = blockIdx.x * 4 + wave; row < NTOK; row += stride) {
    const float* mod = p.mod + ((size_t)l * 3 + (row < NCTX ? 0 : 1 + ((row - NCTX) >> 11))) * 6144;
    const float* sc = mod + (which ? 4096 : 1024);
    const float* sh = mod + (which ? 3072 : 0);
    f32x4 v[4], scv[4], shv[4];
    const float* xr = (l == 0 && which == 0) ? ((row < NCTX) ? (p.x_prompt + (size_t)row * DM) : (p.x_sample + (size_t)(row - NCTX) * DM)) : (p.out + (size_t)row * DM);
#pragma unroll
    for (int i = 0; i < 4; ++i) v[i] = *(const f32x4*)(xr + i * 256 + lane * 4);
#pragma unroll
    for (int i = 0; i < 4; ++i) { scv[i] = *(const f32x4*)(sc + i * 256 + lane * 4); shv[i] = *(const f32x4*)(sh + i * 256 + lane * 4); }
    float ssq = 0.f;
#pragma unroll
    for (int i = 0; i < 4; ++i) ssq += v[i][0] * v[i][0] + v[i][1] * v[i][1] + v[i][2] * v[i][2] + v[i][3] * v[i][3];
    ssq += __shfl_xor(ssq, 1); ssq += __shfl_xor(ssq, 2); ssq += __shfl_xor(ssq, 4); ssq += __shfl_xor(ssq, 8);
    ssq += __shfl_xor(ssq, 16); ssq += __shfl_xor(ssq, 32);
    const float r = rsqrtf(ssq * (1.f / 1024.f) + EPS);
#pragma unroll
    for (int i = 0; i < 4; ++i) {
      f32x4 o;
#pragma unroll
      for (int e = 0; e < 4; ++e) o[e] = v[i][e] * r * (nv[i][e] * (1.f + scv[i][e])) + shv[i][e];
      u32x2 w = {pk2(o[0], o[1]), pk2(o[2], o[3])};
      *(u32x2*)(p.h + (size_t)row * DM + i * 256 + lane * 4) = w;
    }
  }
}

DI int cond_of_row(int row) { return row < NCTX ? 0 : 1 + ((row - NCTX) >> 11); }

DI float red16(float v) { v += __shfl_xor(v, 1); v += __shfl_xor(v, 2); v += __shfl_xor(v, 4); v += __shfl_xor(v, 8); return v; }
DI float red32(float v) { v = red16(v); v += __shfl_xor(v, 16); return v; }
DI void st_bf4(u16* dst, f32x4 v) { u32x2 o = {pk2(v[0], v[1]), pk2(v[2], v[3])}; *(u32x2*)dst = o; }

DI f32x4 rope64(f32x4 v, int j16, int prow, int pcol, const float* tabs) {
  const int sec = j16 >> 3; const int pos = sec ? pcol : prow;
  const int fi = (j16 & 3) * 4;
  const f32x4 cs = *(const f32x4*)(tabs + pos * 16 + fi);
  const f32x4 sn = *(const f32x4*)(tabs + 1024 + pos * 16 + fi);
  f32x4 pv; pv[0] = __shfl_xor(v[0], 4); pv[1] = __shfl_xor(v[1], 4); pv[2] = __shfl_xor(v[2], 4); pv[3] = __shfl_xor(v[3], 4);
  const float sgn = ((j16 & 7) < 4) ? -1.f : 1.f;
  f32x4 o;
#pragma unroll
  for (int i = 0; i < 4; ++i) o[i] = v[i] * cs[i] + sgn * pv[i] * sn[i];
  return o;
}
DI f32x4 rope32(f32x4 v, int jj, int prow, int pcol, const float* tabs) {
  const int sec = jj >> 2; const int pos = sec ? pcol : prow;
  const int fi = (jj & 1) * 4;
  const f32x4 cs = *(const f32x4*)(tabs + 2048 + pos * 8 + fi);
  const f32x4 sn = *(const f32x4*)(tabs + 2560 + pos * 8 + fi);
  f32x4 pv; pv[0] = __shfl_xor(v[0], 2); pv[1] = __shfl_xor(v[1], 2); pv[2] = __shfl_xor(v[2], 2); pv[3] = __shfl_xor(v[3], 2);
  const float sgn = ((jj & 3) < 2) ? -1.f : 1.f;
  f32x4 o;
#pragma unroll
  for (int i = 0; i < 4; ++i) o[i] = v[i] * cs[i] + sgn * pv[i] * sn[i];
  return o;
}

DI void mla_tile(const u16* Aptr, const u16* Wtl  , int hd, const float* kpe_src, int kpe_ld, const float* knd,
                 bool lat, int s0  , const float* tabs,
                 u16* kout  , u16* vout  , char* smem, G2Regs& R) {
  f32x16 acc[2][2]; zero_acc(acc);
  { const G2Ptrs Pm = g2_ptrs(Aptr, 128, Wtl + (size_t)hd * 128 * 128, 128, 0); g2_prefetch(R, Pm); g2_main(acc, R, Pm, 128, smem); }
  float* Cs = (float*)smem;
  const int tid = tidx(), lane = tid & 63, wave = tid >> 6, r32 = lane & 31, hi = lane >> 5, wm = wave >> 1, wn = wave & 1;
  const int j16 = tid & 15;
  for (int half = 0; half < 2; ++half) {
    __syncthreads();
    if (wm == half) {
#pragma unroll
      for (int i = 0; i < 2; ++i)
#pragma unroll
        for (int j = 0; j < 2; ++j)
#pragma unroll
          for (int r = 0; r < 16; ++r) Cs[(i * 32 + r32) * 132 + wn * 64 + j * 32 + crow(r, hi)] = acc[i][j][r];
    }
    __syncthreads();
#pragma unroll
    for (int it = 0; it < 4; ++it) {
      const int rl = it * 16 + (tid >> 4);
      const int rowt = half * 64 + rl;
      f32x4 kn = *(const f32x4*)(Cs + rl * 132 + j16 * 4);
      f32x4 kp = {0.f, 0.f, 0.f, 0.f};
      if (j16 < 8) kp = *(const f32x4*)(kpe_src + (size_t)rowt * kpe_ld + j16 * 4);
      float ssq = kn[0] * kn[0] + kn[1] * kn[1] + kn[2] * kn[2] + kn[3] * kn[3] + kp[0] * kp[0] + kp[1] * kp[1] + kp[2] * kp[2] + kp[3] * kp[3];
      ssq = red16(ssq);
      const float r = rsqrtf(ssq * (1.f / 96.f) + EPS);
      const f32x4 g0 = *(const f32x4*)(knd + j16 * 4);
      f32x4 g1 = {0.f, 0.f, 0.f, 0.f};
      if (j16 < 8) g1 = *(const f32x4*)(knd + 64 + j16 * 4);
#pragma unroll
      for (int i = 0; i < 4; ++i) { kn[i] = kn[i] * r * g0[i]; kp[i] = kp[i] * r * g1[i]; }
      if (lat) {
        const int s = s0 + rowt;
        kp = rope32(kp, j16 & 7, s >> 6, s & 63, tabs);
      }
      st_bf4(kout + (size_t)rowt * 96 + j16 * 4, kn);
      if (j16 < 8) st_bf4(kout + (size_t)rowt * 96 + 64 + j16 * 4, kp);
      const f32x4 vv = *(const f32x4*)(Cs + rl * 132 + 64 + j16 * 4);
      st_bf4(vout + (size_t)rowt * 64 + j16 * 4, vv);
    }
  }
}

#define CTRL_MLACNT(l, mt) (3776 + 64 * (l) + (mt))

DI int virt_col(int n) {
  if (n < 1792) return n;
  if (n < 2176) { const int h = (n - 1792) / 96, e = (n - 1792) % 96; return 1792 + h * 128 + e; }
  if (n < 2304) return 2304 + (n - 2176);
  if (n < 2336) return 2432 + (n - 2304);
  return 2560 + (n - 2336);
}

DI void phase_g1(const Params& p, int l, char* smem) {
  const int NT = 64 * 52;
  const u16* W = p.Wt_in + (size_t)l * INP * DM;
  float* Cs = (float*)smem;
  const float *qn_a = p.qn_a, *qn_b = p.qn_b, *qn_c = p.qn_c, *kn_b = p.kn_b, *kn_c = p.kn_c;
  asm volatile("" : "+s"(qn_a), "+s"(qn_b), "+s"(qn_c), "+s"(kn_b), "+s"(kn_c));
  u16* const qkv = p.QA;
  constexpr size_t E4 = (size_t)4 * NTOK * 64, E2 = (size_t)2 * NTOK * 64;
  G2Regs R; G2Ptrs P;
  if ((int)blockIdx.x < NT) { const int t0 = blockIdx.x; P = g2_ptrs(p.h + (size_t)(t0 & 63) * 128 * DM, DM, W + (size_t)(t0 >> 6) * 128 * DM, DM, 0); g2_prefetch(R, P); }
  const bool swap_last = (gridDim.x == 512);
  auto remap = [&](int tl) { return (swap_last && tl >= 3072 && tl < 3584) ? ((tl < 3328) ? tl + 256 : tl - 256) : tl; };
  for (int tl = blockIdx.x; tl < NT + 272; tl += gridDim.x) {
    const int t = remap(tl);
    if (t >= NT) {
      const int it = t - NT;
      const u16* Wtl = p.Wt_ukv + (size_t)l * 512 * 128;
      if (it < 256) {
        const int mt = it & 63, hd = it >> 6;
        const int m0 = mt * 128;
        if (threadIdx.x == 0) {
          unsigned* c = p.ctrl + CTRL_MLACNT(l, mt);
          XB_SPIN(xb_ld(c) < 2u, p.ctrl);
          __builtin_amdgcn_fence(__ATOMIC_ACQUIRE, "agent");
          asm volatile("s_waitcnt vmcnt(0)" ::: "memory");
        }
        __syncthreads();
        const bool lat = m0 >= NCTX;
        const int s0 = lat ? ((m0 - NCTX) & 2047) : (m0 & 255);
        mla_tile(p.ckvn + (size_t)m0 * 128, Wtl, hd, p.kpe + (size_t)m0 * 32, 32,
                 p.kn_d + l * 96, lat, s0, p.tabs, p.KD + ((size_t)hd * NTOK + m0) * 96, p.VD + ((size_t)hd * NTOK + m0) * 64, smem, R);
      } else {
        const int tt = it - 256;
        const int hd = tt & 3, mt2 = (tt >> 2) & 1, b = (tt >> 3) & 1;
        const size_t rbase = ((size_t)(b * 4 + l) * 256 + mt2 * 128);
        const size_t obase = ((size_t)(l * 2 + b) * 4 + hd) * 256 + mt2 * 128;
        mla_tile(p.cckv + rbase * 128, Wtl, hd, p.c_mla_kpe + rbase * 32, 32,
                 p.kn_d + l * 96, false, 0, p.tabs, p.CKD + obase * 96, p.CVD + obase * 64, smem, R);
      }
      continue;
    }
    const int mt = t & 63, nt = t >> 6;
    const int m0 = mt * 128, n0 = nt * 128;
    f32x16 acc[2][2]; zero_acc(acc);
    g2_main(acc, R, P, DM, smem);
    {
      const int tln = tl + gridDim.x;
      const int tn = (tln < NT + 272) ? remap(tln) : NT;
      if (tn < NT) { P = g2_ptrs(p.h + (size_t)(tn & 63) * 128 * DM, DM, W + (size_t)(tn >> 6) * 128 * DM, DM, 0); g2_prefetch(R, P); }
    }
    const int tid = tidx(), lane = tid & 63, wave = tid >> 6, r32 = lane & 31, hi = lane >> 5, wm = wave >> 1, wn = wave & 1;
    if (nt >= 20) {
#pragma unroll
      for (int i = 0; i < 2; ++i)
#pragma unroll
        for (int j = 0; j < 2; ++j) {
          u16* q = p.gates + (size_t)(m0 + wm * 64 + i * 32 + r32) * 4096 + (n0 - 2560) + wn * 64 + j * 32 + 4 * hi;
#pragma unroll
          for (int g = 0; g < 4; ++g) {
            u32x2 w = {pk2(sigmoidf_(acc[i][j][4 * g]), sigmoidf_(acc[i][j][4 * g + 1])), pk2(sigmoidf_(acc[i][j][4 * g + 2]), sigmoidf_(acc[i][j][4 * g + 3]))};
            *(u32x2*)(q + 8 * g) = w;
          }
        }
      continue;
    }
#pragma unroll
    for (int i = 0; i < 2; ++i)
#pragma unroll
      for (int j = 0; j < 2; ++j)
#pragma unroll
        for (int g = 0; g < 4; ++g) {
          f32x4 v = {acc[i][j][4 * g], acc[i][j][4 * g + 1], acc[i][j][4 * g + 2], acc[i][j][4 * g + 3]};
          *(f32x4*)(Cs + (wm * 64 + i * 32 + r32) * 132 + wn * 64 + j * 32 + 8 * g + 4 * hi) = v;
        }
    __syncthreads();
    const bool lat = m0 >= NCTX;
    const int bb = lat ? ((m0 - NCTX) >> 11) : (m0 >> 8);
    const int sbase = lat ? ((m0 - NCTX) & 2047) : (m0 & 255);
    if (nt < 14) {
      const int c = nt >> 1, half = nt & 1;
      const int j16 = tid & 15, hsel = (tid >> 4) & 1, hh = half * 2 + hsel;
      f32x4 gn = {1.f, 1.f, 1.f, 1.f};
      if (c == 0 || c == 3 || c == 5) gn = *(const f32x4*)((c == 0 ? qn_a : c == 3 ? qn_b : qn_c) + l * 64 + j16 * 4);
      else if (c == 1) gn = *(const f32x4*)(p.kn_a + l * 64 + j16 * 4);
      else if (c != 2 && half == 0) gn = *(const f32x4*)((c == 4 ? kn_b : kn_c) + l * 64 + j16 * 4);
      for (int ps = 0; ps < 16; ++ps) {
        const int rowl = ps * 8 + (tid >> 5);
        const int tok = m0 + rowl, s = sbase + rowl;
        const int prow = s >> 6, pcol = s & 63;
        const size_t cbase = ((size_t)(bb * 4 + l) * 256 + s);
        f32x4 v = *(const f32x4*)(Cs + rowl * 132 + hsel * 64 + j16 * 4);
        const float ssq = red16(v[0] * v[0] + v[1] * v[1] + v[2] * v[2] + v[3] * v[3]);
        const float r = rsqrtf(ssq * (1.f / 64.f) + EPS);
        if (c == 0 || c == 3 || c == 5) {
#pragma unroll
          for (int e = 0; e < 4; ++e) v[e] = v[e] * r * gn[e];
          if (lat && c != 0) v = rope64(v, j16, prow, pcol, p.tabs);
#pragma unroll
          for (int e = 0; e < 4; ++e) v[e] *= QS64;
          st_bf4(qkv + (size_t)c * E4 + ((size_t)hh * NTOK + tok) * 64 + j16 * 4, v);
        } else if (c == 1) {
#pragma unroll
          for (int e = 0; e < 4; ++e) v[e] = v[e] * r * gn[e];
          if (!lat) *(f32x4*)(p.out + O_NATK + cbase * 256 + hh * 64 + j16 * 4) = v;
          st_bf4(p.KA + ((size_t)hh * NTOK + tok) * 64 + j16 * 4, v);
        } else if (c == 2) {
          if (!lat) *(f32x4*)(p.out + O_NATV + cbase * 256 + hh * 64 + j16 * 4) = v;
          st_bf4(p.VA + ((size_t)hh * NTOK + tok) * 64 + j16 * 4, v);
        } else if (half == 0) {
#pragma unroll
          for (int e = 0; e < 4; ++e) v[e] = v[e] * r * gn[e];
          if (!lat) *(f32x4*)(p.out + (c == 4 ? O_GQAK : O_WINK) + cbase * 128 + hsel * 64 + j16 * 4) = v;
          if (lat) v = rope64(v, j16, prow, pcol, p.tabs);
          st_bf4(qkv + (size_t)c * E4 + ((size_t)hsel * NTOK + tok) * 64 + j16 * 4, v);
        } else {
          if (!lat) *(f32x4*)(p.out + (c == 4 ? O_GQAV : O_WINV) + cbase * 128 + hsel * 64 + j16 * 4) = v;
          st_bf4(qkv + (size_t)c * E4 + E2 + ((size_t)hsel * NTOK + tok) * 64 + j16 * 4, v);
        }
      }
    } else if (nt < 18) {
      const int head = nt - 14, l32 = tid & 31;
      const bool actv = l32 < 24;
      f32x4 g = {0.f, 0.f, 0.f, 0.f};
      if (actv) g = *(const f32x4*)(p.qn_d + l * 96 + l32 * 4);
      for (int ps = 0; ps < 16; ++ps) {
        const int rowl = ps * 8 + (tid >> 5);
        const int tok = m0 + rowl, s = sbase + rowl;
        f32x4 v = {0.f, 0.f, 0.f, 0.f};
        if (actv) v = *(const f32x4*)(Cs + rowl * 132 + l32 * 4);
        const float ssq = red32(v[0] * v[0] + v[1] * v[1] + v[2] * v[2] + v[3] * v[3]);
        const float r = rsqrtf(ssq * (1.f / 96.f) + EPS);
#pragma unroll
        for (int e = 0; e < 4; ++e) v[e] = v[e] * r * g[e];
        if (lat) {
          const f32x4 rv = rope32(v, (l32 - 16) & 7, s >> 6, s & 63, p.tabs);
          if (l32 >= 16 && l32 < 24) v = rv;
        }
#pragma unroll
        for (int e = 0; e < 4; ++e) v[e] *= QS96;
        if (actv) st_bf4(p.QD + ((size_t)head * NTOK + tok) * 96 + l32 * 4, v);
      }
    } else if (nt == 18) {
      const int l32 = tid & 31;
      const f32x4 g = *(const f32x4*)(p.kvn_d + l * 128 + l32 * 4);
      for (int ps = 0; ps < 16; ++ps) {
        const int rowl = ps * 8 + (tid >> 5);
        const int tok = m0 + rowl, s = sbase + rowl;
        f32x4 v = *(const f32x4*)(Cs + rowl * 132 + l32 * 4);
        const float ssq = red32(v[0] * v[0] + v[1] * v[1] + v[2] * v[2] + v[3] * v[3]);
        const float r = rsqrtf(ssq * (1.f / 128.f) + EPS);
#pragma unroll
        for (int e = 0; e < 4; ++e) v[e] = v[e] * r * g[e];
        if (!lat) *(f32x4*)(p.out + O_CKV + ((size_t)(bb * 4 + l) * 256 + s) * 128 + l32 * 4) = v;
        st_bf4(p.ckvn + (size_t)tok * 128 + l32 * 4, v);
      }
    } else {
      const int j8 = tid & 7;
      for (int ps = 0; ps < 4; ++ps) {
        const int rowl = ps * 32 + (tid >> 3);
        const int tok = m0 + rowl, s = sbase + rowl;
        const f32x4 v = *(const f32x4*)(Cs + rowl * 132 + j8 * 4);
        if (!lat) *(f32x4*)(p.out + O_KPE + ((size_t)(bb * 4 + l) * 256 + s) * 32 + j8 * 4) = v;
        *(f32x4*)(p.kpe + (size_t)tok * 32 + j8 * 4) = v;
      }
    }
    if (nt == 18 || nt == 19) {
      asm volatile("s_waitcnt vmcnt(0)" ::: "memory");
      __syncthreads();
      if (threadIdx.x == 0) {
        __builtin_amdgcn_fence(__ATOMIC_RELEASE, "agent");
        asm volatile("s_waitcnt vmcnt(0)" ::: "memory");
        xb_add(p.ctrl + CTRL_MLACNT(l, mt), 1u);
      }
    }
  }
}

DI s16x4 vtr(const u16* pp) { return __builtin_bit_cast(s16x4, __builtin_amdgcn_ds_read_tr16_b64_v4i16((LAS v4i16_t*)(pp))); }

template <int DQ>
DI void attn_run(const u16* qptr, int nt0, const u16* k0p, const u16* v0p, int nt1, const u16* k1p, const u16* v1p,
                 int mode, int kpos1, int qpos0, bool has_sink, float sink2, const float* rpb_g, u16* outp, char* smem) {
  constexpr int DQ16 = DQ / 16, KS = DQ + 8, NKR = DQ / 32, CPR = DQ / 8;
  constexpr int BUFE = 64 * KS + 64 * 72;
  u16* Ks0 = (u16*)smem; float* rpb_s = (float*)(Ks0 + 2 * BUFE);
  const int tid = tidx(), lane = tid & 63, wave = tid >> 6, r32 = lane & 31, hi = lane >> 5;
  __syncthreads();
  if (mode == 2) { for (int i = tid; i < 465; i += 256) rpb_s[i] = rpb_g[i] * LOG2E; }
  bf16x8 qf[DQ16];
  {
    const u16* qrow = qptr + (size_t)(wave * 32 + r32) * DQ + hi * 8;
#pragma unroll
    for (int d0 = 0; d0 < DQ16; ++d0) qf[d0] = *(const bf16x8*)(qrow + d0 * 16);
  }
  f32x16 o0, o1;
#pragma unroll
  for (int r = 0; r < 16; ++r) { o0[r] = 0.f; o1[r] = 0.f; }
  float m = 0.f, lsum = 0.f;
  f32x16 negm;
#pragma unroll
  for (int r = 0; r < 16; ++r) negm[r] = 0.f;
  const int ntot = nt0 + nt1;
  u32x4 kr[NKR], vr[2];
  auto issue = [&](int t) {
    const u16* kp = (t < nt0) ? (k0p + (size_t)t * 64 * DQ) : (k1p + (size_t)(t - nt0) * 64 * DQ);
    const u16* vp = (t < nt0) ? (v0p + (size_t)t * 64 * 64) : (v1p + (size_t)(t - nt0) * 64 * 64);
#pragma unroll
    for (int i = 0; i < NKR; ++i) kr[i] = *(const u32x4*)(kp + (size_t)(i * 256 + tid) * 8);
#pragma unroll
    for (int i = 0; i < 2; ++i) vr[i] = *(const u32x4*)(vp + (size_t)(i * 256 + tid) * 8);
  };
  auto stage = [&](int buf) {
    u16* Ks = Ks0 + buf * BUFE; u16* Vs = Ks + 64 * KS;
#pragma unroll
    for (int i = 0; i < NKR; ++i) { const int c = i * 256 + tid; const int row = c / CPR, col = c % CPR; *(u32x4*)(Ks + row * KS + col * 8) = kr[i]; }
#pragma unroll
    for (int i = 0; i < 2; ++i) { const int c = i * 256 + tid; const int row = c >> 3, col = c & 7; *(u32x4*)(Vs + row * 72 + col * 8) = vr[i]; }
  };
  issue(0);
  stage(0);
  if (ntot > 1) issue(1);
  __syncthreads();
  const int qpos = qpos0 + wave * 32 + r32;
  const int qr = qpos >> 6, qc = qpos & 63;
  int r0q = qr - 4; r0q = r0q < 0 ? 0 : (r0q > 24 ? 24 : r0q);
  int c0q = qc - 8; c0q = c0q < 0 ? 0 : (c0q > 48 ? 48 : c0q);
  const int vofs = 64 * KS + (4 * hi + ((lane & 15) >> 2)) * 72 + ((lane >> 4) & 1) * 16 + (lane & 3) * 4;
  for (int t = 0; t < ntot; ++t) {
    const u16* Ks = Ks0 + (t & 1) * BUFE;
    const u16* vbase = Ks + vofs;
    f32x16 p0 = negm, p1 = negm;
#pragma unroll
    for (int d0 = 0; d0 < DQ16; ++d0) {
      const bf16x8 ka = *(const bf16x8*)(Ks + r32 * KS + d0 * 16 + hi * 8);
      const bf16x8 kb = *(const bf16x8*)(Ks + (32 + r32) * KS + d0 * 16 + hi * 8);
      p0 = MFMA(ka, qf[d0], p0); p1 = MFMA(kb, qf[d0], p1);
    }
    if (t >= nt0 && mode != 0) {
      const int kt = t - nt0;
      if (mode == 1) {
        const int kb0 = kpos1 + kt * 64;
#pragma unroll
        for (int r = 0; r < 16; ++r) {
          const int kp = kb0 + crow(r, hi);
          int d = qpos - kp; d = d < 0 ? -d : d;
          if (d > 128) p0[r] = -1e30f;
          int d2 = qpos - (kp + 32); d2 = d2 < 0 ? -d2 : d2;
          if (d2 > 128) p1[r] = -1e30f;
        }
      } else {
        const int krow_ = kpos1 + kt;
        const bool rowok = (krow_ >= r0q) && (krow_ < r0q + 8);
        const int dr = krow_ - qr + 7;
#pragma unroll
        for (int r = 0; r < 16; ++r) {
          {
            const int kc = crow(r, hi);
            const bool ok = rowok && (kc >= c0q) && (kc < c0q + 16);
            int dc = kc - qc; dc = dc < -15 ? -15 : (dc > 15 ? 15 : dc);
            const int idx = ok ? (dr * 31 + dc + 15) : 0;
            const float bv = rpb_s[idx];
            p0[r] = ok ? p0[r] + bv : -1e30f;
          }
          {
            const int kc = 32 + crow(r, hi);
            const bool ok = rowok && (kc >= c0q) && (kc < c0q + 16);
            int dc = kc - qc; dc = dc < -15 ? -15 : (dc > 15 ? 15 : dc);
            const int idx = ok ? (dr * 31 + dc + 15) : 0;
            const float bv = rpb_s[idx];
            p1[r] = ok ? p1[r] + bv : -1e30f;
          }
        }
      }
    }
    float mxa = fmaxf(fmaxf(p0[0], p0[1]), p1[0]), mxb = fmaxf(fmaxf(p0[2], p0[3]), p1[1]);
    mxa = fmaxf(fmaxf(mxa, p1[2]), p1[3]);
#pragma unroll
    for (int r = 4; r < 16; r += 4) {
      mxa = fmaxf(fmaxf(mxa, p0[r]), p0[r + 1]); mxb = fmaxf(fmaxf(mxb, p0[r + 2]), p0[r + 3]);
      mxa = fmaxf(fmaxf(mxa, p1[r]), p1[r + 1]); mxb = fmaxf(fmaxf(mxb, p1[r + 2]), p1[r + 3]);
    }
    float mx = fmaxf(mxa, mxb);
    mx = fmaxf(mx, __shfl_xor(mx, 32));
    if (__builtin_amdgcn_ballot_w64(mx > 8.f) != 0ull) {
      const float d = (mx > 8.f) ? mx : 0.f;
      const float alpha = ex2(-d);
      m += d; lsum *= alpha;
#pragma unroll
      for (int r = 0; r < 16; ++r) { o0[r] *= alpha; o1[r] *= alpha; p0[r] -= d; p1[r] -= d; negm[r] = -m; }
    }
    float rs = 0.f;
#pragma unroll
    for (int r = 0; r < 16; ++r) { p0[r] = ex2(p0[r]); p1[r] = ex2(p1[r]); rs += p0[r] + p1[r]; }
    lsum += rs;
    if (t + 1 < ntot) { stage((t + 1) & 1); if (t + 2 < ntot) issue(t + 2); }
#pragma unroll
    for (int s = 0; s < 4; ++s) {
      u32x4 pw;
      if (s < 2) { pw[0] = pk2(p0[8 * s + 0], p0[8 * s + 1]); pw[1] = pk2(p0[8 * s + 2], p0[8 * s + 3]); pw[2] = pk2(p0[8 * s + 4], p0[8 * s + 5]); pw[3] = pk2(p0[8 * s + 6], p0[8 * s + 7]); }
      else { const int ss = s - 2; pw[0] = pk2(p1[8 * ss + 0], p1[8 * ss + 1]); pw[1] = pk2(p1[8 * ss + 2], p1[8 * ss + 3]); pw[2] = pk2(p1[8 * ss + 4], p1[8 * ss + 5]); pw[3] = pk2(p1[8 * ss + 6], p1[8 * ss + 7]); }
      const bf16x8 pf = __builtin_bit_cast(bf16x8, pw);
      const u16* vb = vbase + (16 * s) * 72;
      {
        const s16x4 lo = vtr(vb), hi4 = vtr(vb + 8 * 72);
        const bf16x8 vf = __builtin_shufflevector(lo, hi4, 0, 1, 2, 3, 4, 5, 6, 7);
        o0 = MFMA(vf, pf, o0);
      }
      {
        const s16x4 lo = vtr(vb + 32), hi4 = vtr(vb + 8 * 72 + 32);
        const bf16x8 vf = __builtin_shufflevector(lo, hi4, 0, 1, 2, 3, 4, 5, 6, 7);
        o1 = MFMA(vf, pf, o1);
      }
    }
    __syncthreads();
  }
  float lt = lsum + __shfl_xor(lsum, 32);
  if (has_sink) lt += ex2(sink2 - m);
  const float inv = 1.f / lt;
  u16* orow = outp + (size_t)(wave * 32 + r32) * 1024;
#pragma unroll
  for (int g = 0; g < 4; ++g) {
    u32x2 w0 = {pk2(o0[4 * g] * inv, o0[4 * g + 1] * inv), pk2(o0[4 * g + 2] * inv, o0[4 * g + 3] * inv)};
    *(u32x2*)(orow + 8 * g + 4 * hi) = w0;
    u32x2 w1 = {pk2(o1[4 * g] * inv, o1[4 * g + 1] * inv), pk2(o1[4 * g + 2] * inv, o1[4 * g + 3] * inv)};
    *(u32x2*)(orow + 32 + 8 * g + 4 * hi) = w1;
  }
}

DI void attn_item(const Params& p, int l, int item, char* smem) {
  int mix, lat, b, h, qt;
  if (item < 512) {
    const int g = item >> 7; mix = (g == 0) ? 3 : (g == 1) ? 1 : (g == 2) ? 0 : 2; lat = 1;
    const int i = item & 127; b = i >> 6; h = (i >> 4) & 3; qt = i & 15;
  } else {
    const int g = (item - 512) >> 7; mix = (g == 0) ? 3 : (g - 1); lat = 0;
    const int i = item & 127; b = i >> 3; h = (i >> 1) & 3; qt = i & 1;
  }
  const int tb = lat ? (NCTX + b * 2048) : (b * 256);
  const int q0 = qt * 128;
  const int hkv = (mix == 1 || mix == 2) ? (h >> 1) : h;
  const int HKV = (mix == 1 || mix == 2) ? 2 : 4;
  u16* outp = p.br + (size_t)(tb + q0) * 1024 + mix * 256 + h * 64;
  const bool has_sink = (mix == 2);
  const float sink2 = has_sink ? p.sink_c[l * 4 + h] * LOG2E : 0.f;
  const u16 *Q, *K, *V, *CK, *CV;
  if (mix == 0) { Q = p.QA; K = p.KA; V = p.VA; CK = p.CKA; CV = p.CVA; }
  else if (mix == 1) { Q = p.QB; K = p.KB; V = p.VB; CK = p.CKB; CV = p.CVB; }
  else if (mix == 2) { Q = p.QC; K = p.KC; V = p.VC; CK = p.CKC; CV = p.CVC; }
  else { Q = p.QD; K = p.KD; V = p.VD; CK = p.CKD; CV = p.CVD; }
  const int DQ = (mix == 3) ? 96 : 64;
  const u16* qptr = Q + ((size_t)h * NTOK + tb + q0) * DQ;
  const u16* kown = K + ((size_t)hkv * NTOK + tb) * DQ;
  const u16* vown = V + ((size_t)hkv * NTOK + tb) * 64;
  int nt0, nt1 = 0, mode = 0, kpos1 = 0;
  const u16 *k0p, *v0p, *k1p = kown, *v1p = vown;
  if (!lat) { nt0 = 4; k0p = kown; v0p = vown; }
  else {
    nt0 = 4;
    const size_t cs = ((size_t)(l * 2 + b) * HKV + hkv) * 256;
    k0p = CK + cs * DQ; v0p = CV + cs * 64;
    if (mix == 1 || mix == 3) { nt1 = 32; }
    else if (mix == 2) {
      int lo = q0 - 128; if (lo < 0) lo = 0; int hi_ = q0 + 256; if (hi_ > 2048) hi_ = 2048;
      nt1 = (hi_ - lo) >> 6; kpos1 = lo; mode = 1;
      k1p = kown + (size_t)lo * DQ; v1p = vown + (size_t)lo * 64;
    } else {
      const int R = qt * 2;
      int ra = R - 4; ra = ra < 0 ? 0 : (ra > 24 ? 24 : ra);
      int rb = R + 1 - 4; rb = rb < 0 ? 0 : (rb > 24 ? 24 : rb);
      nt1 = rb + 8 - ra; kpos1 = ra; mode = 2;
      k1p = kown + (size_t)ra * 64 * DQ; v1p = vown + (size_t)ra * 64 * 64;
    }
  }
  const float* rpb_g = p.rpb_a + ((size_t)l * 4 + h) * 465;
  if (mix == 3) attn_run<96>(qptr, nt0, k0p, v0p, nt1, k1p, v1p, mode, kpos1, q0, has_sink, sink2, rpb_g, outp, smem);
  else attn_run<64>(qptr, nt0, k0p, v0p, nt1, k1p, v1p, mode, kpos1, q0, has_sink, sink2, rpb_g, outp, smem);
}

DI void phase_attn(const Params& p, int l, char* smem, LAS unsigned* s_item) {
  unsigned* ctr = p.ctrl + CTRL_QUEUE(l);
  for (;;) {
    __syncthreads();
    if (tidx() == 0) *s_item = atomicAdd(ctr, 1u);
    __syncthreads();
    const int item = (int)*s_item;
    if (item >= 1024) break;
    attn_item(p, l, item, smem);
  }
}

DI void phase_merge(const Params& p, int l, char* smem) {
  const u16* W = p.Wt_br + (size_t)l * DM * DM;
  u16* S = (u16*)smem;
  for (int t = blockIdx.x; t < 512; t += gridDim.x) {
    const int mt = t & 63, nt = t >> 6;
    const int m0 = mt * 128, n0 = nt * 128;
    const int tid = tidx(), lane = tid & 63, wave = tid >> 6, r32 = lane & 31, hi = lane >> 5, wm = wave >> 1, wn = wave & 1;
    const int lr = tid >> 3, lc = (tid & 7) * 8;
    const u16* ap = p.br + (size_t)(m0 + lr) * 1024 + lc;
    const u16* bp = W + (size_t)(n0 + lr) * DM + lc;
    f32x16 tot[2][2], acc[2][2]; zero_acc(tot); zero_acc(acc);
    u32x4 ra[4], rb[4];
    __syncthreads();
#pragma unroll
    for (int i = 0; i < 4; ++i) { ra[i] = *(const u32x4*)(ap + (size_t)i * 32 * 1024); rb[i] = *(const u32x4*)(bp + (size_t)i * 32 * DM); }
#pragma unroll 1
    for (int n = 0; n < 4; ++n) {
#pragma unroll
      for (int kq = 0; kq < 4; ++kq) {
        const int kt = n * 4 + kq, cur = kq & 1;
        {
          u16* As_ = S + cur * 2 * STG + lr * LDS_LD + lc; u16* Bs_ = As_ + STG;
#pragma unroll
          for (int i = 0; i < 4; ++i) { *(u32x4*)(As_ + i * 32 * LDS_LD) = ra[i]; *(u32x4*)(Bs_ + i * 32 * LDS_LD) = rb[i]; }
        }
        __syncthreads();
        {
          const int kn = (kt + 1 < 16) ? kt + 1 : 15;
#pragma unroll
          for (int i = 0; i < 4; ++i) { ra[i] = *(const u32x4*)(ap + (size_t)i * 32 * 1024 + kn * 64); rb[i] = *(const u32x4*)(bp + (size_t)i * 32 * DM + kn * 64); }
        }
        const u16* As_ = S + cur * 2 * STG; const u16* Bs_ = As_ + STG;
#pragma unroll
        for (int ks = 0; ks < 4; ++ks) {
          const bf16x8 a0 = *(const bf16x8*)(As_ + (wm * 64 + r32) * LDS_LD + ks * 16 + hi * 8);
          const bf16x8 a1 = *(const bf16x8*)(As_ + (wm * 64 + 32 + r32) * LDS_LD + ks * 16 + hi * 8);
          const bf16x8 b0 = *(const bf16x8*)(Bs_ + (wn * 64 + r32) * LDS_LD + ks * 16 + hi * 8);
          const bf16x8 b1 = *(const bf16x8*)(Bs_ + (wn * 64 + 32 + r32) * LDS_LD + ks * 16 + hi * 8);
          acc[0][0] = MFMA(b0, a0, acc[0][0]); acc[0][1] = MFMA(b1, a0, acc[0][1]);
          acc[1][0] = MFMA(b0, a1, acc[1][0]); acc[1][1] = MFMA(b1, a1, acc[1][1]);
        }
      }
      int gofs = (m0 + wm * 64 + r32) * 4096 + n * 1024 + n0 + wn * 64 + 4 * hi;
      asm volatile("" : "+v"(gofs));
      const u16* gb = p.gates;
#pragma unroll
      for (int i = 0; i < 2; ++i)
#pragma unroll
        for (int j = 0; j < 2; ++j) {
          asm volatile("" ::: "memory");
#pragma unroll
          for (int g = 0; g < 4; ++g) {
            const u32x2 gw = *(const u32x2*)(gb + gofs + i * 32 * 4096 + j * 32 + 8 * g);
            tot[i][j][4 * g + 0] += bf_lo(gw[0]) * acc[i][j][4 * g + 0];
            tot[i][j][4 * g + 1] += bf_hi(gw[0]) * acc[i][j][4 * g + 1];
            tot[i][j][4 * g + 2] += bf_lo(gw[1]) * acc[i][j][4 * g + 2];
            tot[i][j][4 * g + 3] += bf_hi(gw[1]) * acc[i][j][4 * g + 3];
            acc[i][j][4 * g + 0] = 0.f; acc[i][j][4 * g + 1] = 0.f; acc[i][j][4 * g + 2] = 0.f; acc[i][j][4 * g + 3] = 0.f;
          }
        }
    }
#pragma unroll
    for (int i = 0; i < 2; ++i)
#pragma unroll
      for (int j = 0; j < 2; ++j) {
        u16* q = p.merged + (size_t)(m0 + wm * 64 + i * 32 + r32) * DM + n0 + wn * 64 + j * 32 + 4 * hi;
#pragma unroll
        for (int g = 0; g < 4; ++g) {
          u32x2 w = {pk2(tot[i][j][4 * g], tot[i][j][4 * g + 1]), pk2(tot[i][j][4 * g + 2], tot[i][j][4 * g + 3])};
          *(u32x2*)(q + 8 * g) = w;
        }
      }
  }
}

DI void phase_outproj(const Params& p, int l, char* smem) {
  const u16* W = p.Wt_out + (size_t)l * DM * DM;
  for (int t = blockIdx.x; t < 512; t += gridDim.x) {
    const int mt = t & 63, nt = t >> 6;
    const int m0 = mt * 128, n0 = nt * 128;
    f32x16 acc[2][2]; zero_acc(acc);
    gemm2(acc, p.merged + (size_t)m0 * DM, DM, W + (size_t)n0 * DM, DM, DM, smem);
    const float* mod = p.mod + ((size_t)l * 3 + cond_of_row(m0)) * 6144;
    const float* xin = (l == 0) ? ((m0 < NCTX) ? (p.x_prompt + (size_t)m0 * DM) : (p.x_sample + (size_t)(m0 - NCTX) * DM)) : (p.out + (size_t)m0 * DM);
    epi_residual(acc, p.out, xin, mod + 2048, m0, n0);
  }
}

struct ConvW { f32x4 wa0, wa1, wa2, wg0, wg1, wg2, ba, bg; };
DI ConvW conv_load(const float* cw, const float* cb, int ca_col) {
  ConvW w;
  w.wa0 = *(const f32x4*)(cw + ca_col); w.wa1 = *(const f32x4*)(cw + UPC + ca_col); w.wa2 = *(const f32x4*)(cw + 2 * UPC + ca_col);
  w.wg0 = *(const f32x4*)(cw + DFF + ca_col); w.wg1 = *(const f32x4*)(cw + UPC + DFF + ca_col); w.wg2 = *(const f32x4*)(cw + 2 * UPC + DFF + ca_col);
  w.ba = *(const f32x4*)(cb + ca_col); w.bg = *(const f32x4*)(cb + DFF + ca_col);
  return w;
}
DI void conv_act4(const f32x4& ua, const f32x4& ca, const f32x4& da, const f32x4& ug, const f32x4& cg, const f32x4& dg, const ConvW& w, u16* dst) {
  float o[4];
#pragma unroll
  for (int e = 0; e < 4; ++e) {
    const float a = w.ba[e] + w.wa0[e] * ua[e] + w.wa1[e] * ca[e] + w.wa2[e] * da[e];
    const float g = w.bg[e] + w.wg0[e] * ug[e] + w.wg1[e] * cg[e] + w.wg2[e] * dg[e];
    o[e] = siluf_(g) * a;
  }
  u32x2 pk = {pk2(o[0], o[1]), pk2(o[2], o[3])};
  *(u32x2*)dst = pk;
}

DI void phase_up(const Params& p, int l, char* smem) {
  const u16* W = p.Wt_up + (size_t)l * UPC * DM;
  const float* cw = p.conv_w + (size_t)l * 3 * UPC;
  const float* cb = p.conv_b + (size_t)l * UPC;
  float* Cs = (float*)smem;
  const int NT = 64 * 44;
  G2Regs R; G2Ptrs P;
  const size_t bex = (size_t)(DFF - 64) * DM;
  if ((int)blockIdx.x < NT) { const int t0 = blockIdx.x; P = g2_ptrs(p.h + (size_t)(t0 & 63) * 128 * DM, DM, W + (size_t)(t0 >> 6) * 64 * DM, DM, bex); g2_prefetch(R, P); }
  for (int t = blockIdx.x; t < NT; t += gridDim.x) {
    const int mt = t & 63, nt = t >> 6;
    const int m0 = mt * 128, n0 = nt * 64;
    f32x16 acc[2][2]; zero_acc(acc);
    g2_main(acc, R, P, DM, smem);
    {
      const int tn = t + gridDim.x;
      if (tn < NT) { P = g2_ptrs(p.h + (size_t)(tn & 63) * 128 * DM, DM, W + (size_t)(tn >> 6) * 64 * DM, DM, bex); g2_prefetch(R, P); }
    }
    const int tid = tidx(), lane = tid & 63, wave = tid >> 6, r32 = lane & 31, hi = lane >> 5, wm = wave >> 1, wn = wave & 1;
#pragma unroll
    for (int i = 0; i < 2; ++i)
#pragma unroll
      for (int j = 0; j < 2; ++j)
#pragma unroll
        for (int g = 0; g < 4; ++g) {
          f32x4 v = {acc[i][j][4 * g], acc[i][j][4 * g + 1], acc[i][j][4 * g + 2], acc[i][j][4 * g + 3]};
          *(f32x4*)(Cs + (wm * 64 + i * 32 + r32) * 132 + wn * 64 + j * 32 + 8 * g + 4 * hi) = v;
        }
    __syncthreads();
    const int T = (m0 < NCTX) ? 256 : 2048;
    const int s0 = (m0 < NCTX) ? (m0 & 255) : ((m0 - NCTX) & 2047);
    const bool first = (s0 == 0), last = (s0 + 128 == T);
    const int c4 = (tid & 15) * 4;
    const f32x4 z4 = {0.f, 0.f, 0.f, 0.f};
    const ConvW cwt = conv_load(cw, cb, n0 + c4);
#pragma unroll 2
    for (int k = 0; k < 8; ++k) {
      const int row = (tid >> 4) + 16 * k;
      if ((row == 0 && !first) || (row == 127 && !last)) continue;
      const float* cr = Cs + row * 132 + c4;
      const f32x4 ca = *(const f32x4*)cr, cg = *(const f32x4*)(cr + 64);
      f32x4 ua = z4, ug = z4, da = z4, dg = z4;
      if (row > 0) { ua = *(const f32x4*)(cr - 132); ug = *(const f32x4*)(cr - 132 + 64); }
      if (row < 127) { da = *(const f32x4*)(cr + 132); dg = *(const f32x4*)(cr + 132 + 64); }
      conv_act4(ua, ca, da, ug, cg, dg, cwt, p.act + (size_t)(m0 + row) * DFF + n0 + c4);
    }
    if (tid < 128) {
      const int gc = (tid < 64) ? (n0 + tid) : (DFF + n0 + tid - 64);
      float* ubp = p.ub + (size_t)mt * 4 * UPC + gc;
      ubp[0] = Cs[0 * 132 + tid]; ubp[UPC] = Cs[1 * 132 + tid]; ubp[2 * UPC] = Cs[126 * 132 + tid]; ubp[3 * UPC] = Cs[127 * 132 + tid];
    }
  }
}

DI void phase_down(const Params& p, int l, char* smem) {
  const u16* W = p.Wt_down + (size_t)l * DM * DFF;
  const float* cw = p.conv_w + (size_t)l * 3 * UPC;
  const float* cb = p.conv_b + (size_t)l * UPC;
  for (int t = blockIdx.x; t < 512; t += gridDim.x) {
    const int mt = t & 63, nt = t >> 6;
    const int m0 = mt * 128, n0 = nt * 128;
    {
      const int tid = tidx();
      const int T = (m0 < NCTX) ? 256 : 2048;
      const int s0 = (m0 < NCTX) ? (m0 & 255) : ((m0 - NCTX) & 2047);
      const bool first = (s0 == 0), last = (s0 + 128 == T);
      for (int idx = tid; idx < 2 * 704; idx += 256) {
        const int rsel = idx / 704, c4 = (idx % 704) * 4;
        if ((rsel == 0 && first) || (rsel == 1 && last)) continue;
        const float* u_up = rsel ? (p.ub + ((size_t)mt * 4 + 2) * UPC) : (p.ub + ((size_t)(mt - 1) * 4 + 3) * UPC);
        const float* u_cu = rsel ? (p.ub + ((size_t)mt * 4 + 3) * UPC) : (p.ub + ((size_t)mt * 4 + 0) * UPC);
        const float* u_dn = rsel ? (p.ub + ((size_t)(mt + 1) * 4 + 0) * UPC) : (p.ub + ((size_t)mt * 4 + 1) * UPC);
        const f32x4 ua = *(const f32x4*)(u_up + c4), ca = *(const f32x4*)(u_cu + c4), da = *(const f32x4*)(u_dn + c4);
        const f32x4 ug = *(const f32x4*)(u_up + DFF + c4), cg = *(const f32x4*)(u_cu + DFF + c4), dg = *(const f32x4*)(u_dn + DFF + c4);
        const ConvW cwt = conv_load(cw, cb, c4);
        conv_act4(ua, ca, da, ug, cg, dg, cwt, p.act + (size_t)(m0 + (rsel ? 127 : 0)) * DFF + c4);
      }
      asm volatile("s_waitcnt vmcnt(0)" ::: "memory");
    }
    f32x16 acc[2][2]; zero_acc(acc);
    gemm2(acc, p.act + (size_t)m0 * DFF, DFF, W + (size_t)n0 * DFF, DFF, DFF, smem);
    const float* mod = p.mod + ((size_t)l * 3 + cond_of_row(m0)) * 6144;
    epi_residual(acc, p.out, p.out + (size_t)m0 * DM, mod + 5120, m0, n0);
  }
}

DI void phase_prologue(const Params& p, char* smem) {
  const int tid = tidx(), lane = tid & 63, wave = tid >> 6;
  for (int item = blockIdx.x; item < 384; item += gridDim.x) {
    {
      const int l = item / 96, cg = item % 96;
      float* sc = (float*)smem;
      float* red = sc + 3072;
      __syncthreads();
      for (int i = tid; i < 3072; i += 256) {
        const int c = i >> 10, k = i & 1023;
        const float v = (c == 0) ? p.c_ctx[k] : p.c[(c - 1) * 1024 + k];
        sc[i] = siluf_(v);
      }
      __syncthreads();
      const int cl = tid & 15, kg = tid >> 4;
      const float* w = p.w_ada + ((size_t)l * 1024 + kg * 64) * 6144 + cg * 64 + cl * 4;
      f32x4 a0 = {0, 0, 0, 0}, a1 = {0, 0, 0, 0}, a2 = {0, 0, 0, 0};
#pragma unroll 16
      for (int k = 0; k < 64; ++k) {
        const f32x4 wv = __builtin_nontemporal_load((const f32x4*)(w + (size_t)k * 6144));
        const float s0 = sc[kg * 64 + k], s1 = sc[1024 + kg * 64 + k], s2 = sc[2048 + kg * 64 + k];
#pragma unroll
        for (int e = 0; e < 4; ++e) { a0[e] += s0 * wv[e]; a1[e] += s1 * wv[e]; a2[e] += s2 * wv[e]; }
      }
      *(f32x4*)(red + (kg * 3 + 0) * 64 + cl * 4) = a0;
      *(f32x4*)(red + (kg * 3 + 1) * 64 + cl * 4) = a1;
      *(f32x4*)(red + (kg * 3 + 2) * 64 + cl * 4) = a2;
      __syncthreads();
      if (tid < 192) {
        const int c = tid >> 6, col = tid & 63;
        float s = 0.f;
#pragma unroll
        for (int g = 0; g < 16; ++g) s += red[(g * 3 + c) * 64 + col];
        const int cc = cg * 64 + col;
        p.mod[((size_t)l * 3 + c) * 6144 + cc] = s + p.b_ada[(size_t)l * 6144 + cc];
      }
    }
  }
  for (int i = blockIdx.x * 256 + tid; i < 2 * 4 * 256 * 128 / 8; i += gridDim.x * 256) {
    const f32x4 v0 = *(const f32x4*)(p.c_mla_ckv + (size_t)i * 8), v1 = *(const f32x4*)(p.c_mla_ckv + (size_t)i * 8 + 4);
    u32x4 o = {pk2(v0[0], v0[1]), pk2(v0[2], v0[3]), pk2(v1[0], v1[1]), pk2(v1[2], v1[3])};
    *(u32x4*)(p.cckv + (size_t)i * 8) = o;
  }
  {
    float* T = (float*)smem;
    for (int t = blockIdx.x; t < 4 * 4256; t += gridDim.x) {
      const int l = t / 4256; int r = t % 4256;
      const float* W; u16* D; int K, N, kt, nt;
      bool isin = false;
      if (r < 1616) { W = p.w_in + (size_t)l * DM * INC; D = p.Wt_in + (size_t)l * INP * DM; K = DM; N = INC; nt = r % 101; kt = r / 101; isin = true; }
      else if ((r -= 1616) < 1408) { W = p.w_up + (size_t)l * DM * UPC; D = p.Wt_up + (size_t)l * UPC * DM; K = DM; N = UPC; nt = r % 88; kt = r / 88; }
      else if ((r -= 1408) < 704) { W = p.w_down + (size_t)l * DFF * DM; D = p.Wt_down + (size_t)l * DM * DFF; K = DFF; N = DM; nt = r & 15; kt = r >> 4; }
      else if ((r -= 704) < 256) { W = p.w_out + (size_t)l * DM * DM; D = p.Wt_out + (size_t)l * DM * DM; K = DM; N = DM; nt = r & 15; kt = r >> 4; }
      else if ((r -= 256) < 256) { W = p.w_branch + (size_t)l * DM * DM; D = p.Wt_br + (size_t)l * DM * DM; K = DM; N = DM; nt = r & 15; kt = r >> 4; }
      else { r -= 256; W = p.w_ukv + (size_t)l * 128 * 512; D = p.Wt_ukv + (size_t)l * 512 * 128; K = 128; N = 512; nt = r & 7; kt = r >> 3; }
      const int k0 = kt * 64, n0 = nt * 64;
      __syncthreads();
      {
        const int c4 = (tid & 15) * 4, rr = tid >> 4;
        const bool ok = (n0 + c4) < N;
#pragma unroll
        for (int i = 0; i < 4; ++i) {
          f32x4 v = {0.f, 0.f, 0.f, 0.f};
          if (ok) v = __builtin_nontemporal_load((const f32x4*)(W + (size_t)(k0 + i * 16 + rr) * N + n0 + c4));
          float* tp = T + (i * 16 + rr) * 65 + c4;
          tp[0] = v[0]; tp[1] = v[1]; tp[2] = v[2]; tp[3] = v[3];
        }
      }
      __syncthreads();
      {
        const int kc = (tid & 7) * 8;
#pragma unroll
        for (int ps = 0; ps < 2; ++ps) {
          const int n = ps * 32 + (tid >> 3);
          if (n0 + n < N) {
            const float* tp = T + kc * 65 + n;
            u32x4 o = {pk2(tp[0], tp[65]), pk2(tp[2 * 65], tp[3 * 65]), pk2(tp[4 * 65], tp[5 * 65]), pk2(tp[6 * 65], tp[7 * 65])};
            const int drow = isin ? virt_col(n0 + n) : (n0 + n);
            *(u32x4*)(D + (size_t)drow * K + k0 + kc) = o;
          }
        }
      }
    }
  }
  const int gt = blockIdx.x * 256 + tid, gs = gridDim.x * 256;
  for (int it = gt; it < 2 * 65536 + 4 * 32768; it += gs) {
    const float* src; u16* dst; int H, i;
    if (it < 65536) { src = p.c_nat_k; dst = p.CKA; H = 4; i = it; }
    else if (it < 131072) { src = p.c_nat_v; dst = p.CVA; H = 4; i = it - 65536; }
    else {
      const int j = it - 131072; const int w = j >> 15; i = j & 32767; H = 2;
      src = (w == 0) ? p.c_gqa_k : (w == 1) ? p.c_gqa_v : (w == 2) ? p.c_win_k : p.c_win_v;
      dst = (w == 0) ? p.CKB : (w == 1) ? p.CVB : (w == 2) ? p.CKC : p.CVC;
    }
    const int d8 = i & 7, s = (i >> 3) & 255;
    int rest = i >> 11; const int h = rest % H; rest /= H; const int b = rest & 1, l = rest >> 1;
    const float* sp = src + (((size_t)(b * 4 + l) * 256 + s) * H + h) * 64 + d8 * 8;
    const f32x4 v0 = *(const f32x4*)sp, v1 = *(const f32x4*)(sp + 4);
    u32x4 o = {pk2(v0[0], v0[1]), pk2(v0[2], v0[3]), pk2(v1[0], v1[1]), pk2(v1[2], v1[3])};
    *(u32x4*)(dst + ((((size_t)(l * 2 + b) * H + h) * 256 + s) * 64 + d8 * 8)) = o;
  }
  for (int i = gt; i < 1536; i += gs) {
    if (i < 1024) {
      const int pos = i >> 4, f = i & 15;
      const float inv = exp2f(-13.287712379549449f * (float)(2 * f) / 32.f);
      const float ang = (float)pos * inv;
      p.tabs[i] = cosf(ang); p.tabs[1024 + i] = sinf(ang);
    } else {
      const int j = i - 1024; const int pos = j >> 3, f = j & 7;
      const float inv = exp2f(-13.287712379549449f * (float)(2 * f) / 16.f);
      const float ang = (float)pos * inv;
      p.tabs[2048 + j] = cosf(ang); p.tabs[2560 + j] = sinf(ang);
    }
  }
}

__global__ void __launch_bounds__(256, 2) mega_kernel(Params p, int ph_lo, int ph_hi) {
  __shared__ __attribute__((aligned(16))) char smem[SMEM_BYTES];
  __shared__ uint4 xb_words;
  __shared__ unsigned s_item_w[4];
  if (tidx() == 0) xb_words = make_uint4(0u, 0u, 0u, 0u);
  __syncthreads();
  XcdBarrier bar; bar.bar = p.ctrl; bar.x = 0; bar.st = (volatile LAS unsigned*)&xb_words;
  if (ph_hi - ph_lo > 1) bar = xcd_barrier_post(p.ctrl, (volatile LAS unsigned*)&xb_words);
  for (int ph = ph_lo; ph < ph_hi; ++ph) {
    if (ph == 0) phase_prologue(p, smem);
    else {
      const int l = (ph - 1) / 8, s = (ph - 1) % 8;
      switch (s) {
        case 0: phase_norm(p, l, 0); break;
        case 1: phase_g1(p, l, smem); break;
        case 2: phase_attn(p, l, smem, (LAS unsigned*)s_item_w); break;
        case 3: phase_merge(p, l, smem); break;
        case 4: phase_outproj(p, l, smem); break;
        case 5: phase_norm(p, l, 1); break;
        case 6: phase_up(p, l, smem); break;
        default: phase_down(p, l, smem); break;
      }
    }
    if (ph + 1 < ph_hi) xcd_barrier(bar);
  }
}

static inline size_t align_up(size_t x) { return (x + 255) & ~(size_t)255; }

extern "C" void kernel_launch(void* const* d_in, const int* in_sizes, int n_in, void* d_out, int out_size, void* d_ws, size_t ws_size,
                              hipStream_t stream) {
  Params p{};
  const float** fp = (const float**)&p;
  for (int i = 0; i < 35; ++i) fp[i] = (const float*)d_in[i];
  p.out = (float*)d_out;
  char* w = (char*)d_ws; size_t off = 0;
  auto take = [&](size_t bytes) { void* r = w + off; off = align_up(off + bytes); return r; };
  p.ctrl = (unsigned*)take(CTRL_WORDS * 4);
  p.mod = (float*)take((size_t)4 * 3 * 6144 * 4);
  p.tabs = (float*)take(3072 * 4);
  {
    void* ur = take((size_t)NTOK * UPC * 2);
    p.proj = (float*)ur; p.u = (u16*)ur; p.ub = (float*)ur;
  }
  p.gates = (u16*)take((size_t)NTOK * 4096 * 2);
  p.QA = (u16*)take((size_t)4 * NTOK * 64 * 2); p.KA = (u16*)take((size_t)4 * NTOK * 64 * 2); p.VA = (u16*)take((size_t)4 * NTOK * 64 * 2);
  p.QB = (u16*)take((size_t)4 * NTOK * 64 * 2); p.KB = (u16*)take((size_t)2 * NTOK * 64 * 2); p.VB = (u16*)take((size_t)2 * NTOK * 64 * 2);
  p.QC = (u16*)take((size_t)4 * NTOK * 64 * 2); p.KC = (u16*)take((size_t)2 * NTOK * 64 * 2); p.VC = (u16*)take((size_t)2 * NTOK * 64 * 2);
  p.QD = (u16*)take((size_t)4 * NTOK * 96 * 2); p.KD = (u16*)take((size_t)4 * NTOK * 96 * 2); p.VD = (u16*)take((size_t)4 * NTOK * 64 * 2);
  p.act = p.QA;
  p.ckvn = (u16*)take((size_t)NTOK * 128 * 2);
  p.br = (u16*)take((size_t)NTOK * 1024 * 2);
  p.merged = (u16*)take((size_t)NTOK * 1024 * 2);
  p.h = p.merged;
  p.CKA = (u16*)take((size_t)4 * 2 * 4 * 256 * 64 * 2); p.CVA = (u16*)take((size_t)4 * 2 * 4 * 256 * 64 * 2);
  p.CKB = (u16*)take((size_t)4 * 2 * 2 * 256 * 64 * 2); p.CVB = (u16*)take((size_t)4 * 2 * 2 * 256 * 64 * 2);
  p.CKC = (u16*)take((size_t)4 * 2 * 2 * 256 * 64 * 2); p.CVC = (u16*)take((size_t)4 * 2 * 2 * 256 * 64 * 2);
  p.CKD = (u16*)take((size_t)4 * 2 * 4 * 256 * 96 * 2); p.CVD = (u16*)take((size_t)4 * 2 * 4 * 256 * 64 * 2);
  p.cckv = (u16*)take((size_t)2 * 4 * 256 * 128 * 2);
  p.kpe = (float*)take((size_t)NTOK * 32 * 4);
  p.Wt_in = (u16*)take((size_t)4 * INP * DM * 2);
  p.Wt_up = (u16*)take((size_t)4 * UPC * DM * 2);
  p.Wt_down = (u16*)take((size_t)4 * DM * DFF * 2);
  p.Wt_out = (u16*)take((size_t)4 * DM * DM * 2);
  p.Wt_br = (u16*)take((size_t)4 * DM * DM * 2);
  p.Wt_ukv = (u16*)take((size_t)4 * 512 * 128 * 2);
  if (off > ws_size) fprintf(stderr, "workspace too small: need %zu have %zu\n", off, ws_size);

  static int grid_blocks = 0;
  if (!grid_blocks) {
    int dev = 0, cus = 0, per_cu = 0;
    hipGetDevice(&dev);
    hipDeviceGetAttribute(&cus, hipDeviceAttributeMultiprocessorCount, dev);
    hipOccupancyMaxActiveBlocksPerMultiprocessor(&per_cu, mega_kernel, 256, 0);
    if (per_cu > 2) per_cu = 2;
    if (per_cu < 1) per_cu = 1;
    grid_blocks = cus * per_cu;
  }
  hipMemsetAsync(p.ctrl, 0, CTRL_WORDS * 4, stream);
#if SINGLE_LAUNCH
  int lo = 0, hi = NPHASE;
  void* args[] = {&p, &lo, &hi};
  hipError_t e = hipLaunchCooperativeKernel((void*)mega_kernel, dim3(grid_blocks), dim3(256), args, 0, stream);
  if (e != hipSuccess) fprintf(stderr, "cooperative launch failed: %s (grid %d)\n", hipGetErrorString(e), grid_blocks);
#else
  for (int ph = 0; ph < NPHASE; ++ph) mega_kernel<<<grid_blocks, 256, 0, stream>>>(p, ph, ph + 1);
#endif
}
```

```cpp
#include <hip/hip_runtime.h>
#include <stdint.h>
#include <stdio.h>

#ifndef SINGLE_LAUNCH
#define SINGLE_LAUNCH 1
#endif

typedef unsigned short u16;
typedef short bf16x8 __attribute__((ext_vector_type(8)));
typedef short s16x4 __attribute__((ext_vector_type(4)));
typedef float f32x16 __attribute__((ext_vector_type(16)));
typedef float f32x4 __attribute__((ext_vector_type(4)));
typedef unsigned u32x4 __attribute__((ext_vector_type(4)));
typedef unsigned u32x2 __attribute__((ext_vector_type(2)));
typedef __bf16 bf2_t __attribute__((ext_vector_type(2)));
typedef float f2_t __attribute__((ext_vector_type(2)));
typedef short v4i16_t __attribute__((ext_vector_type(4)));

#define DI __device__ __forceinline__
#define MFMA(a, b, c) __builtin_amdgcn_mfma_f32_32x32x16_bf16((a), (b), (c), 0, 0, 0)
#define LAS __attribute__((address_space(3)))

DI unsigned pk2(float a, float b) { f2_t v = {a, b}; return __builtin_bit_cast(unsigned, __builtin_convertvector(v, bf2_t)); }
DI float bf_lo(unsigned u) { return __uint_as_float(u << 16); }
DI float bf_hi(unsigned u) { return __uint_as_float(u & 0xffff0000u); }
DI int crow(int r, int hi) { return (r & 3) + 8 * (r >> 2) + 4 * hi; }
DI float ex2(float x) { return __builtin_amdgcn_exp2f(x); }
constexpr float LOG2E_ = 1.4426950408889634f;
DI float sigmoidf_(float x) { return __builtin_amdgcn_rcpf(1.f + ex2(-LOG2E_ * x)); }
DI float siluf_(float x) { return x * __builtin_amdgcn_rcpf(1.f + ex2(-LOG2E_ * x)); }
DI int tidx() { int t = threadIdx.x; asm volatile("" : "+v"(t)); return t; }

constexpr int NTOK = 8192, NCTX = 4096, DM = 1024, INC = 6432, PROJC = 2336, DFF = 2816, UPC = 5632, DEPTH = 4;
constexpr float EPS = 1e-6f;
constexpr float LOG2E = 1.4426950408889634f;
constexpr float QS64 = 0.125f * LOG2E;
constexpr float QS96 = 0.10206207261596575f * LOG2E;
constexpr int NPHASE = 1 + 8 * DEPTH;
constexpr int SMEM_BYTES = 73728;
constexpr int INP = 6656;

constexpr size_t O_X = 0, O_NATK = 8388608, O_NATV = 12582912, O_GQAK = 16777216, O_GQAV = 18874368,
                 O_WINK = 20971520, O_WINV = 23068672, O_CKV = 25165824, O_KPE = 27262976;

struct Params {
  const float *x_prompt, *x_sample, *c_nat_k, *c_nat_v, *c_gqa_k, *c_gqa_v, *c_win_k, *c_win_v, *c_mla_ckv, *c_mla_kpe;
  const float *c, *c_ctx, *w_ada, *b_ada, *norm1, *norm2, *w_in, *qn_a, *kn_a, *rpb_a, *qn_b, *kn_b, *qn_c, *kn_c, *sink_c;
  const float *qn_d, *kn_d, *kvn_d, *w_ukv, *w_branch, *w_out, *w_up, *conv_w, *conv_b, *w_down;
  float* out;
  unsigned* ctrl;
  float* mod;
  float* tabs;
  float* proj;
  u16* gates;
  u16 *QA, *KA, *VA, *QB, *KB, *VB, *QC, *KC, *VC, *QD, *KD, *VD;
  u16* ckvn;
  u16* br;
  u16* merged;
  u16* u;
  u16* act;
  u16 *CKA, *CVA, *CKB, *CVB, *CKC, *CVC, *CKD, *CVD;
  u16 *Wt_in, *Wt_up, *Wt_down, *Wt_out, *Wt_br, *Wt_ukv;
  float* ub;
  float* kpe;
  u16* cckv;
  u16* h;
};

#define XB_TMO      128
#define XB_XCNT(j)  (256  + 64 * (j))
#define XB_XSUB(j)  (1280 + 64 * (j))
#define XB_XGEN(j)  (2304 + 64 * (j))
#define XB_TOP      3328
#define XB_TOPGEN   3392
#define XCD_BAR_WORDS 3456
#define CTRL_QUEUE(l) (3520 + 64 * (l))
#define CTRL_WORDS 4096
#define XB_SPIN_CAP (1u << 22)
DI unsigned xb_ld(unsigned* p) { return __hip_atomic_load(p, __ATOMIC_RELAXED, __HIP_MEMORY_SCOPE_AGENT); }
DI unsigned xb_add(unsigned* p, unsigned v) { return __hip_atomic_fetch_add(p, v, __ATOMIC_RELAXED, __HIP_MEMORY_SCOPE_AGENT); }
DI unsigned xb_xcc_id() { return (unsigned)__builtin_amdgcn_s_getreg((3 << 11) | 20) & 0xFu; }
#define XB_SPIN(cond, bar) do { unsigned _sp = 0; while (cond) { __builtin_amdgcn_s_sleep(1); \
    if ((++_sp & 255u) == 0u) { if (xb_ld(&(bar)[XB_TMO])) break; if (_sp > XB_SPIN_CAP) { atomicAdd(&(bar)[XB_TMO], 1u); break; } } } } while (0)
struct XcdBarrier { unsigned* bar; unsigned x; volatile LAS unsigned* st; };
DI XcdBarrier xcd_barrier_post(unsigned* bar, volatile LAS unsigned* st) {
  XcdBarrier b; b.bar = bar; b.x = xb_xcc_id(); b.st = st;
  if (threadIdx.x == 0) (void)xb_add(&bar[XB_XCNT(b.x)], 1u);
  return b;
}
DI void xcd_barrier_complete(unsigned* bar, unsigned x, unsigned& nloc, unsigned& nx) {
  const unsigned G = gridDim.x * gridDim.y * gridDim.z;
  unsigned sum, cnt, mine, sp = 0u;
  for (;;) {
    sum = 0u; cnt = 0u; mine = 0u;
#pragma unroll
    for (unsigned j = 0; j < 16; ++j) { const unsigned c = xb_ld(&bar[XB_XCNT(j)]); sum += c; cnt += (c > 0u) ? 1u : 0u; mine = (j == x) ? c : mine; }
    if (sum == G) break;
    __builtin_amdgcn_s_sleep(1);
    if ((++sp & 255u) == 0u) { if (xb_ld(&bar[XB_TMO])) break; if (sp > XB_SPIN_CAP) { atomicAdd(&bar[XB_TMO], 1u); break; } }
  }
  nloc = mine > 0u ? mine : 1u; nx = cnt > 0u ? cnt : 1u;
}
DI void xcd_barrier(const XcdBarrier& b) {
  asm volatile("s_waitcnt vmcnt(0)" ::: "memory");
  __syncthreads();
  if (threadIdx.x == 0) {
    unsigned* bar = b.bar;
    __builtin_amdgcn_s_waitcnt(0);
    unsigned nloc = b.st[0], nx = b.st[1];
    if (nloc == 0u) { xcd_barrier_complete(bar, b.x, nloc, nx); b.st[0] = nloc; b.st[1] = nx; }
    const unsigned old = xb_add(&bar[XB_XSUB(b.x)], 1u);
    const unsigned gen = old / nloc;
    if (old + 1u == (gen + 1u) * nloc) {
      __builtin_amdgcn_fence(__ATOMIC_RELEASE, "agent");
      asm volatile("s_waitcnt vmcnt(0)" ::: "memory");
      const unsigned og = xb_add(&bar[XB_TOP], 1u);
      const unsigned tg = og / nx;
      if (og + 1u == (tg + 1u) * nx) xb_add(&bar[XB_TOPGEN], 1u);
      else XB_SPIN(xb_ld(&bar[XB_TOPGEN]) == tg, bar);
      __builtin_amdgcn_fence(__ATOMIC_ACQUIRE, "agent");
      xb_add(&bar[XB_XGEN(b.x)], 1u);
      asm volatile("s_waitcnt vmcnt(0)" ::: "memory");
    } else {
      XB_SPIN(xb_ld(&bar[XB_XGEN(b.x)]) == gen, bar);
      __builtin_amdgcn_fence(__ATOMIC_ACQUIRE, "agent");
      asm volatile("s_waitcnt vmcnt(0)" ::: "memory");
    }
  }
  __syncthreads();
}

constexpr int LDS_LD = 72;
constexpr int STG = 128 * LDS_LD;

struct G2Regs { u32x4 r0a[4], r0b[4], r1a[4], r1b[4]; };
struct G2Ptrs { const u16* ap; const u16* bp; size_t a32, b32, bextra; };
DI G2Ptrs g2_ptrs(const u16* A, int lda, const u16* Bt, int ldb, size_t bextra) {
  const int tid = tidx();
  const int lr = tid >> 3, lc = (tid & 7) * 8;
  G2Ptrs P; P.ap = A + (size_t)lr * lda + lc; P.bp = Bt + (size_t)lr * ldb + lc; P.a32 = (size_t)32 * lda; P.b32 = (size_t)32 * ldb; P.bextra = bextra;
  return P;
}
#define G2_ISSUE(RA, RB, kt_) do { const u16* a_ = P.ap + (size_t)(kt_) * 64; const u16* b_ = P.bp + (size_t)(kt_) * 64; \
    _Pragma("unroll") for (int i = 0; i < 4; ++i) RA[i] = *(const u32x4*)(a_ + i * P.a32); \
    _Pragma("unroll") for (int i = 0; i < 4; ++i) RB[i] = *(const u32x4*)(b_ + i * P.b32 + (i >= 2 ? P.bextra : (size_t)0)); } while (0)
DI void g2_prefetch(G2Regs& R, const G2Ptrs& P) {
  G2_ISSUE(R.r0a, R.r0b, 0);
  G2_ISSUE(R.r1a, R.r1b, 1);
}
DI void g2_main(f32x16 (&acc)[2][2], G2Regs& R, const G2Ptrs& P, int K, char* smem) {
  u16* S = (u16*)smem;
  const int tid = tidx(), lane = tid & 63, wave = tid >> 6, r32 = lane & 31, hi = lane >> 5;
  const int wm = wave >> 1, wn = wave & 1;
  const int lr = tid >> 3, lc = (tid & 7) * 8;
#define G2_STORE(RA, RB, buf_) do { u16* As_ = S + (buf_) * 2 * STG + lr * LDS_LD + lc; u16* Bs_ = As_ + STG; \
    _Pragma("unroll") for (int i = 0; i < 4; ++i) *(u32x4*)(As_ + i * 32 * LDS_LD) = RA[i]; \
    _Pragma("unroll") for (int i = 0; i < 4; ++i) *(u32x4*)(Bs_ + i * 32 * LDS_LD) = RB[i]; } while (0)
  const u16* afr = S + (wm * 64 + r32) * LDS_LD + hi * 8;
  const u16* bfr = S + STG + (wn * 64 + r32) * LDS_LD + hi * 8;
#define G2_FRAG(buf_, ks_, A0, A1, B0, B1) do { const u16* a_ = afr + (buf_) * 2 * STG + (ks_) * 16; const u16* b_ = bfr + (buf_) * 2 * STG + (ks_) * 16; \
    A0 = *(const bf16x8*)(a_); A1 = *(const bf16x8*)(a_ + 32 * LDS_LD); B0 = *(const bf16x8*)(b_); B1 = *(const bf16x8*)(b_ + 32 * LDS_LD); } while (0)
#define G2_MMA(A0, A1, B0, B1) do { acc[0][0] = MFMA(B0, A0, acc[0][0]); acc[0][1] = MFMA(B1, A0, acc[0][1]); \
    acc[1][0] = MFMA(B0, A1, acc[1][0]); acc[1][1] = MFMA(B1, A1, acc[1][1]); } while (0)
#define G2_COMPUTE(buf_) do { bf16x8 a0, a1, b0, b1, c0, c1, d0, d1; __builtin_amdgcn_iglp_opt(0); \
    G2_FRAG(buf_, 0, a0, a1, b0, b1); G2_FRAG(buf_, 1, c0, c1, d0, d1); __builtin_amdgcn_s_setprio(1); G2_MMA(a0, a1, b0, b1); \
    G2_FRAG(buf_, 2, a0, a1, b0, b1); G2_MMA(c0, c1, d0, d1); \
    G2_FRAG(buf_, 3, c0, c1, d0, d1); G2_MMA(a0, a1, b0, b1); G2_MMA(c0, c1, d0, d1); __builtin_amdgcn_s_setprio(0); } while (0)
  const int KT = K >> 6;
  __syncthreads();
  G2_STORE(R.r0a, R.r0b, 0);
  G2_STORE(R.r1a, R.r1b, 1);
  if (KT > 2) G2_ISSUE(R.r0a, R.r0b, 2);
  if (KT > 3) G2_ISSUE(R.r1a, R.r1b, 3);
  __syncthreads();
  for (int kt = 0; kt < KT; kt += 2) {
    G2_COMPUTE(0);
    __syncthreads();
    if (kt + 2 < KT) {
      G2_STORE(R.r0a, R.r0b, 0);
      if (kt + 4 < KT) G2_ISSUE(R.r0a, R.r0b, kt + 4);
    }
    G2_COMPUTE(1);
    __syncthreads();
    if (kt + 3 < KT) {
      G2_STORE(R.r1a, R.r1b, 1);
      if (kt + 5 < KT) G2_ISSUE(R.r1a, R.r1b, kt + 5);
    }
  }
#undef G2_STORE
#undef G2_FRAG
#undef G2_MMA
#undef G2_COMPUTE
}
DI void gemm2(f32x16 (&acc)[2][2], const u16* A, int lda, const u16* Bt, int ldb, int K, char* smem, size_t bextra = 0) {
  G2Regs R; const G2Ptrs P = g2_ptrs(A, lda, Bt, ldb, bextra);
  g2_prefetch(R, P);
  g2_main(acc, R, P, K, smem);
}

DI void gemm2s(f32x16 (&acc)[2][2], const u16* A, int lda, const u16* Bt, int ldb, int K, char* smem) {
  u16* S = (u16*)smem;
  const int tid = tidx(), lane = tid & 63, wave = tid >> 6, r32 = lane & 31, hi = lane >> 5;
  const int wm = wave >> 1, wn = wave & 1;
  const int lr = tid >> 3, lc = (tid & 7) * 8;
  const u16* ap = A + (size_t)lr * lda + lc;
  const u16* bp = Bt + (size_t)lr * ldb + lc;
  const size_t a32 = (size_t)32 * lda, b32 = (size_t)32 * ldb;
  u32x4 ra[4], rb[4];
  const int KT = K >> 6;
  __syncthreads();
#pragma unroll
  for (int i = 0; i < 4; ++i) { ra[i] = *(const u32x4*)(ap + i * a32); rb[i] = *(const u32x4*)(bp + i * b32); }
#pragma unroll 1
  for (int kt = 0; kt < KT; ++kt) {
    const int cur = kt & 1;
    {
      u16* As_ = S + cur * 2 * STG + lr * LDS_LD + lc; u16* Bs_ = As_ + STG;
#pragma unroll
      for (int i = 0; i < 4; ++i) { *(u32x4*)(As_ + i * 32 * LDS_LD) = ra[i]; *(u32x4*)(Bs_ + i * 32 * LDS_LD) = rb[i]; }
    }
    __syncthreads();
    if (kt + 1 < KT) {
      const u16* a_ = ap + (size_t)(kt + 1) * 64; const u16* b_ = bp + (size_t)(kt + 1) * 64;
#pragma unroll
      for (int i = 0; i < 4; ++i) { ra[i] = *(const u32x4*)(a_ + i * a32); rb[i] = *(const u32x4*)(b_ + i * b32); }
    }
    const u16* As_ = S + cur * 2 * STG; const u16* Bs_ = As_ + STG;
#pragma unroll
    for (int ks = 0; ks < 4; ++ks) {
      const bf16x8 a0 = *(const bf16x8*)(As_ + (wm * 64 + r32) * LDS_LD + ks * 16 + hi * 8);
      const bf16x8 a1 = *(const bf16x8*)(As_ + (wm * 64 + 32 + r32) * LDS_LD + ks * 16 + hi * 8);
      const bf16x8 b0 = *(const bf16x8*)(Bs_ + (wn * 64 + r32) * LDS_LD + ks * 16 + hi * 8);
      const bf16x8 b1 = *(const bf16x8*)(Bs_ + (wn * 64 + 32 + r32) * LDS_LD + ks * 16 + hi * 8);
      acc[0][0] = MFMA(b0, a0, acc[0][0]); acc[0][1] = MFMA(b1, a0, acc[0][1]);
      acc[1][0] = MFMA(b0, a1, acc[1][0]); acc[1][1] = MFMA(b1, a1, acc[1][1]);
    }
  }
  __syncthreads();
}

DI void zero_acc(f32x16 (&acc)[2][2]) {
#pragma unroll
  for (int i = 0; i < 2; ++i)
#pragma unroll
    for (int j = 0; j < 2; ++j)
#pragma unroll
      for (int r = 0; r < 16; ++r) acc[i][j][r] = 0.f;
}

DI void epi_residual(f32x16 (&acc)[2][2], float* x, const float* xin  , const float* gvec, int m0, int n0) {
  const int tid = tidx(), lane = tid & 63, wave = tid >> 6, r32 = lane & 31, hi = lane >> 5;
  const int wm = wave >> 1, wn = wave & 1;
#pragma unroll
  for (int i = 0; i < 2; ++i)
#pragma unroll
    for (int j = 0; j < 2; ++j) {
      const int col = n0 + wn * 64 + j * 32 + 4 * hi;
      float* px = x + (size_t)(m0 + wm * 64 + i * 32 + r32) * DM + col;
      const float* pin = xin + (size_t)(wm * 64 + i * 32 + r32) * DM + col;
#pragma unroll
      for (int g = 0; g < 4; ++g) {
        const f32x4 gv = *(const f32x4*)(gvec + col + 8 * g);
        f32x4 xv = *(const f32x4*)(pin + 8 * g);
#pragma unroll
        for (int e = 0; e < 4; ++e) xv[e] += gv[e] * acc[i][j][4 * g + e];
        *(f32x4*)(px + 8 * g) = xv;
      }
    }
}

DI void phase_norm(const Params& p, int l, int which) {
  const int tid = tidx(), lane = tid & 63, wave = tid >> 6;
  const float* nrm = (which ? p.norm2 : p.norm1) + l * DM;
  const int stride = gridDim.x * 4;
  f32x4 nv[4];
#pragma unroll
  for (int i = 0; i < 4; ++i) nv[i] = *(const f32x4*)(nrm + i * 256 + lane * 4);
  for (int row = blockIdx.x * 4 + wave; row < NTOK; row += stride) {
    const float* mod = p.mod + ((size_t)l * 3 + (row < NCTX ? 0 : 1 + ((row - NCTX) >> 11))) * 6144;
    const float* sc = mod + (which ? 4096 : 1024);
    const float* sh = mod + (which ? 3072 : 0);
    f32x4 v[4], scv[4], shv[4];
    const float* xr = (l == 0 && which == 0) ? ((row < NCTX) ? (p.x_prompt + (size_t)row * DM) : (p.x_sample + (size_t)(row - NCTX) * DM)) : (p.out + (size_t)row * DM);
#pragma unroll
    for (int i = 0; i < 4; ++i) v[i] = *(const f32x4*)(xr + i * 256 + lane * 4);
#pragma unroll
    for (int i = 0; i < 4; ++i) { scv[i] = *(const f32x4*)(sc + i * 256 + lane * 4); shv[i] = *(const f32x4*)(sh + i * 256 + lane * 4); }
    float ssq = 0.f;
#pragma unroll
    for (int i = 0; i < 4; ++i) ssq += v[i][0] * v[i][0] + v[i][1] * v[i][1] + v[i][2] * v[i][2] + v[i][3] * v[i][3];
    ssq += __shfl_xor(ssq, 1); ssq += __shfl_xor(ssq, 2); ssq += __shfl_xor(ssq, 4); ssq += __shfl_xor(ssq, 8);
    ssq += __shfl_xor(ssq, 16); ssq += __shfl_xor(ssq, 32);
    const float r = rsqrtf(ssq * (1.f / 1024.f) + EPS);
#pragma unroll
    for (int i = 0; i < 4; ++i) {
      f32x4 o;
#pragma unroll
      for (int e = 0; e < 4; ++e) o[e] = v[i][e] * r * (nv[i][e] * (1.f + scv[i][e])) + shv[i][e];
      u32x2 w = {pk2(o[0], o[1]), pk2(o[2], o[3])};
      *(u32x2*)(p.h + (size_t)row * DM + i * 256 + lane * 4) = w;
    }
  }
}

DI int cond_of_row(int row) { return row < NCTX ? 0 : 1 + ((row - NCTX) >> 11); }

DI float red16(float v) { v += __shfl_xor(v, 1); v += __shfl_xor(v, 2); v += __shfl_xor(v, 4); v += __shfl_xor(v, 8); return v; }
DI float red32(float v) { v = red16(v); v += __shfl_xor(v, 16); return v; }
DI void st_bf4(u16* dst, f32x4 v) { u32x2 o = {pk2(v[0], v[1]), pk2(v[2], v[3])}; *(u32x2*)dst = o; }

DI f32x4 rope64(f32x4 v, int j16, int prow, int pcol, const float* tabs) {
  const int sec = j16 >> 3; const int pos = sec ? pcol : prow;
  const int fi = (j16 & 3) * 4;
  const f32x4 cs = *(const f32x4*)(tabs + pos * 16 + fi);
  const f32x4 sn = *(const f32x4*)(tabs + 1024 + pos * 16 + fi);
  f32x4 pv; pv[0] = __shfl_xor(v[0], 4); pv[1] = __shfl_xor(v[1], 4); pv[2] = __shfl_xor(v[2], 4); pv[3] = __shfl_xor(v[3], 4);
  const float sgn = ((j16 & 7) < 4) ? -1.f : 1.f;
  f32x4 o;
#pragma unroll
  for (int i = 0; i < 4; ++i) o[i] = v[i] * cs[i] + sgn * pv[i] * sn[i];
  return o;
}
DI f32x4 rope32(f32x4 v, int jj, int prow, int pcol, const float* tabs) {
  const int sec = jj >> 2; const int pos = sec ? pcol : prow;
  const int fi = (jj & 1) * 4;
  const f32x4 cs = *(const f32x4*)(tabs + 2048 + pos * 8 + fi);
  const f32x4 sn = *(const f32x4*)(tabs + 2560 + pos * 8 + fi);
  f32x4 pv; pv[0] = __shfl_xor(v[0], 2); pv[1] = __shfl_xor(v[1], 2); pv[2] = __shfl_xor(v[2], 2); pv[3] = __shfl_xor(v[3], 2);
  const float sgn = ((jj & 3) < 2) ? -1.f : 1.f;
  f32x4 o;
#pragma unroll
  for (int i = 0; i < 4; ++i) o[i] = v[i] * cs[i] + sgn * pv[i] * sn[i];
  return o;
}

DI void mla_tile(const u16* Aptr, const u16* Wtl  , int hd, const float* kpe_src, int kpe_ld, const float* knd,
                 bool lat, int s0  , const float* tabs,
                 u16* kout  , u16* vout  , char* smem, G2Regs& R) {
  f32x16 acc[2][2]; zero_acc(acc);
  { const G2Ptrs Pm = g2_ptrs(Aptr, 128, Wtl + (size_t)hd * 128 * 128, 128, 0); g2_prefetch(R, Pm); g2_main(acc, R, Pm, 128, smem); }
  float* Cs = (float*)smem;
  const int tid = tidx(), lane = tid & 63, wave = tid >> 6, r32 = lane & 31, hi = lane >> 5, wm = wave >> 1, wn = wave & 1;
  const int j16 = tid & 15;
  for (int half = 0; half < 2; ++half) {
    __syncthreads();
    if (wm == half) {
#pragma unroll
      for (int i = 0; i < 2; ++i)
#pragma unroll
        for (int j = 0; j < 2; ++j)
#pragma unroll
          for (int r = 0; r < 16; ++r) Cs[(i * 32 + r32) * 132 + wn * 64 + j * 32 + crow(r, hi)] = acc[i][j][r];
    }
    __syncthreads();
#pragma unroll
    for (int it = 0; it < 4; ++it) {
      const int rl = it * 16 + (tid >> 4);
      const int rowt = half * 64 + rl;
      f32x4 kn = *(const f32x4*)(Cs + rl * 132 + j16 * 4);
      f32x4 kp = {0.f, 0.f, 0.f, 0.f};
      if (j16 < 8) kp = *(const f32x4*)(kpe_src + (size_t)rowt * kpe_ld + j16 * 4);
      float ssq = kn[0] * kn[0] + kn[1] * kn[1] + kn[2] * kn[2] + kn[3] * kn[3] + kp[0] * kp[0] + kp[1] * kp[1] + kp[2] * kp[2] + kp[3] * kp[3];
      ssq = red16(ssq);
      const float r = rsqrtf(ssq * (1.f / 96.f) + EPS);
      const f32x4 g0 = *(const f32x4*)(knd + j16 * 4);
      f32x4 g1 = {0.f, 0.f, 0.f, 0.f};
      if (j16 < 8) g1 = *(const f32x4*)(knd + 64 + j16 * 4);
#pragma unroll
      for (int i = 0; i < 4; ++i) { kn[i] = kn[i] * r * g0[i]; kp[i] = kp[i] * r * g1[i]; }
      if (lat) {
        const int s = s0 + rowt;
        kp = rope32(kp, j16 & 7, s >> 6, s & 63, tabs);
      }
      st_bf4(kout + (size_t)rowt * 96 + j16 * 4, kn);
      if (j16 < 8) st_bf4(kout + (size_t)rowt * 96 + 64 + j16 * 4, kp);
      const f32x4 vv = *(const f32x4*)(Cs + rl * 132 + 64 + j16 * 4);
      st_bf4(vout + (size_t)rowt * 64 + j16 * 4, vv);
    }
  }
}

#define CTRL_MLACNT(l, mt) (3776 + 64 * (l) + (mt))

DI int virt_col(int n) {
  if (n < 1792) return n;
  if (n < 2176) { const int h = (n - 1792) / 96, e = (n - 1792) % 96; return 1792 + h * 128 + e; }
  if (n < 2304) return 2304 + (n - 2176);
  if (n < 2336) return 2432 + (n - 2304);
  return 2560 + (n - 2336);
}

DI void phase_g1(const Params& p, int l, char* smem) {
  const int NT = 64 * 52;
  const u16* W = p.Wt_in + (size_t)l * INP * DM;
  float* Cs = (float*)smem;
  const float *qn_a = p.qn_a, *qn_b = p.qn_b, *qn_c = p.qn_c, *kn_b = p.kn_b, *kn_c = p.kn_c;
  asm volatile("" : "+s"(qn_a), "+s"(qn_b), "+s"(qn_c), "+s"(kn_b), "+s"(kn_c));
  u16* const qkv = p.QA;
  constexpr size_t E4 = (size_t)4 * NTOK * 64, E2 = (size_t)2 * NTOK * 64;
  G2Regs R; G2Ptrs P;
  if ((int)blockIdx.x < NT) { const int t0 = blockIdx.x; P = g2_ptrs(p.h + (size_t)(t0 & 63) * 128 * DM, DM, W + (size_t)(t0 >> 6) * 128 * DM, DM, 0); g2_prefetch(R, P); }
  for (int t = blockIdx.x; t < NT + 272; t += gridDim.x) {
    if (t >= NT) {
      const int it = t - NT;
      const u16* Wtl = p.Wt_ukv + (size_t)l * 512 * 128;
      if (it < 256) {
        const int mt = it & 63, hd = it >> 6;
        const int m0 = mt * 128;
        if (threadIdx.x == 0) {
          unsigned* c = p.ctrl + CTRL_MLACNT(l, mt);
          XB_SPIN(xb_ld(c) < 2u, p.ctrl);
          __builtin_amdgcn_fence(__ATOMIC_ACQUIRE, "agent");
          asm volatile("s_waitcnt vmcnt(0)" ::: "memory");
        }
        __syncthreads();
        const bool lat = m0 >= NCTX;
        const int s0 = lat ? ((m0 - NCTX) & 2047) : (m0 & 255);
        mla_tile(p.ckvn + (size_t)m0 * 128, Wtl, hd, p.kpe + (size_t)m0 * 32, 32,
                 p.kn_d + l * 96, lat, s0, p.tabs, p.KD + ((size_t)hd * NTOK + m0) * 96, p.VD + ((size_t)hd * NTOK + m0) * 64, smem, R);
      } else {
        const int tt = it - 256;
        const int hd = tt & 3, mt2 = (tt >> 2) & 1, b = (tt >> 3) & 1;
        const size_t rbase = ((size_t)(b * 4 + l) * 256 + mt2 * 128);
        const size_t obase = ((size_t)(l * 2 + b) * 4 + hd) * 256 + mt2 * 128;
        mla_tile(p.cckv + rbase * 128, Wtl, hd, p.c_mla_kpe + rbase * 32, 32,
                 p.kn_d + l * 96, false, 0, p.tabs, p.CKD + obase * 96, p.CVD + obase * 64, smem, R);
      }
      continue;
    }
    const int mt = t & 63, nt = t >> 6;
    const int m0 = mt * 128, n0 = nt * 128;
    f32x16 acc[2][2]; zero_acc(acc);
    g2_main(acc, R, P, DM, smem);
    {
      const int tn = t + gridDim.x;
      if (tn < NT) { P = g2_ptrs(p.h + (size_t)(tn & 63) * 128 * DM, DM, W + (size_t)(tn >> 6) * 128 * DM, DM, 0); g2_prefetch(R, P); }
    }
    const int tid = tidx(), lane = tid & 63, wave = tid >> 6, r32 = lane & 31, hi = lane >> 5, wm = wave >> 1, wn = wave & 1;
    if (nt >= 20) {
#pragma unroll
      for (int i = 0; i < 2; ++i)
#pragma unroll
        for (int j = 0; j < 2; ++j) {
          u16* q = p.gates + (size_t)(m0 + wm * 64 + i * 32 + r32) * 4096 + (n0 - 2560) + wn * 64 + j * 32 + 4 * hi;
#pragma unroll
          for (int g = 0; g < 4; ++g) {
            u32x2 w = {pk2(sigmoidf_(acc[i][j][4 * g]), sigmoidf_(acc[i][j][4 * g + 1])), pk2(sigmoidf_(acc[i][j][4 * g + 2]), sigmoidf_(acc[i][j][4 * g + 3]))};
            *(u32x2*)(q + 8 * g) = w;
          }
        }
      continue;
    }
#pragma unroll
    for (int i = 0; i < 2; ++i)
#pragma unroll
      for (int j = 0; j < 2; ++j)
#pragma unroll
        for (int g = 0; g < 4; ++g) {
          f32x4 v = {acc[i][j][4 * g], acc[i][j][4 * g + 1], acc[i][j][4 * g + 2], acc[i][j][4 * g + 3]};
          *(f32x4*)(Cs + (wm * 64 + i * 32 + r32) * 132 + wn * 64 + j * 32 + 8 * g + 4 * hi) = v;
        }
    __syncthreads();
    const bool lat = m0 >= NCTX;
    const int bb = lat ? ((m0 - NCTX) >> 11) : (m0 >> 8);
    const int sbase = lat ? ((m0 - NCTX) & 2047) : (m0 & 255);
    if (nt < 14) {
      const int c = nt >> 1, half = nt & 1;
      const int j16 = tid & 15, hsel = (tid >> 4) & 1, hh = half * 2 + hsel;
      f32x4 gn = {1.f, 1.f, 1.f, 1.f};
      if (c == 0 || c == 3 || c == 5) gn = *(const f32x4*)((c == 0 ? qn_a : c == 3 ? qn_b : qn_c) + l * 64 + j16 * 4);
      else if (c == 1) gn = *(const f32x4*)(p.kn_a + l * 64 + j16 * 4);
      else if (c != 2 && half == 0) gn = *(const f32x4*)((c == 4 ? kn_b : kn_c) + l * 64 + j16 * 4);
      for (int ps = 0; ps < 16; ++ps) {
        const int rowl = ps * 8 + (tid >> 5);
        const int tok = m0 + rowl, s = sbase + rowl;
        const int prow = s >> 6, pcol = s & 63;
        const size_t cbase = ((size_t)(bb * 4 + l) * 256 + s);
        f32x4 v = *(const f32x4*)(Cs + rowl * 132 + hsel * 64 + j16 * 4);
        const float ssq = red16(v[0] * v[0] + v[1] * v[1] + v[2] * v[2] + v[3] * v[3]);
        const float r = rsqrtf(ssq * (1.f / 64.f) + EPS);
        if (c == 0 || c == 3 || c == 5) {
#pragma unroll
          for (int e = 0; e < 4; ++e) v[e] = v[e] * r * gn[e];
          if (lat && c != 0) v = rope64(v, j16, prow, pcol, p.tabs);
#pragma unroll
          for (int e = 0; e < 4; ++e) v[e] *= QS64;
          st_bf4(qkv + (size_t)c * E4 + ((size_t)hh * NTOK + tok) * 64 + j16 * 4, v);
        } else if (c == 1) {
#pragma unroll
          for (int e = 0; e < 4; ++e) v[e] = v[e] * r * gn[e];
          if (!lat) *(f32x4*)(p.out + O_NATK + cbase * 256 + hh * 64 + j16 * 4) = v;
          st_bf4(p.KA + ((size_t)hh * NTOK + tok) * 64 + j16 * 4, v);
        } else if (c == 2) {
          if (!lat) *(f32x4*)(p.out + O_NATV + cbase * 256 + hh * 64 + j16 * 4) = v;
          st_bf4(p.VA + ((size_t)hh * NTOK + tok) * 64 + j16 * 4, v);
        } else if (half == 0) {
#pragma unroll
          for (int e = 0; e < 4; ++e) v[e] = v[e] * r * gn[e];
          if (!lat) *(f32x4*)(p.out + (c == 4 ? O_GQAK : O_WINK) + cbase * 128 + hsel * 64 + j16 * 4) = v;
          if (lat) v = rope64(v, j16, prow, pcol, p.tabs);
          st_bf4(qkv + (size_t)c * E4 + ((size_t)hsel * NTOK + tok) * 64 + j16 * 4, v);
        } else {
          if (!lat) *(f32x4*)(p.out + (c == 4 ? O_GQAV : O_WINV) + cbase * 128 + hsel * 64 + j16 * 4) = v;
          st_bf4(qkv + (size_t)c * E4 + E2 + ((size_t)hsel * NTOK + tok) * 64 + j16 * 4, v);
        }
      }
    } else if (nt < 18) {
      const int head = nt - 14, l32 = tid & 31;
      const bool actv = l32 < 24;
      f32x4 g = {0.f, 0.f, 0.f, 0.f};
      if (actv) g = *(const f32x4*)(p.qn_d + l * 96 + l32 * 4);
      for (int ps = 0; ps < 16; ++ps) {
        const int rowl = ps * 8 + (tid >> 5);
        const int tok = m0 + rowl, s = sbase + rowl;
        f32x4 v = {0.f, 0.f, 0.f, 0.f};
        if (actv) v = *(const f32x4*)(Cs + rowl * 132 + l32 * 4);
        const float ssq = red32(v[0] * v[0] + v[1] * v[1] + v[2] * v[2] + v[3] * v[3]);
        const float r = rsqrtf(ssq * (1.f / 96.f) + EPS);
#pragma unroll
        for (int e = 0; e < 4; ++e) v[e] = v[e] * r * g[e];
        if (lat) {
          const f32x4 rv = rope32(v, (l32 - 16) & 7, s >> 6, s & 63, p.tabs);
          if (l32 >= 16 && l32 < 24) v = rv;
        }
#pragma unroll
        for (int e = 0; e < 4; ++e) v[e] *= QS96;
        if (actv) st_bf4(p.QD + ((size_t)head * NTOK + tok) * 96 + l32 * 4, v);
      }
    } else if (nt == 18) {
      const int l32 = tid & 31;
      const f32x4 g = *(const f32x4*)(p.kvn_d + l * 128 + l32 * 4);
      for (int ps = 0; ps < 16; ++ps) {
        const int rowl = ps * 8 + (tid >> 5);
        const int tok = m0 + rowl, s = sbase + rowl;
        f32x4 v = *(const f32x4*)(Cs + rowl * 132 + l32 * 4);
        const float ssq = red32(v[0] * v[0] + v[1] * v[1] + v[2] * v[2] + v[3] * v[3]);
        const float r = rsqrtf(ssq * (1.f / 128.f) + EPS);
#pragma unroll
        for (int e = 0; e < 4; ++e) v[e] = v[e] * r * g[e];
        if (!lat) *(f32x4*)(p.out + O_CKV + ((size_t)(bb * 4 + l) * 256 + s) * 128 + l32 * 4) = v;
        st_bf4(p.ckvn + (size_t)tok * 128 + l32 * 4, v);
      }
    } else {
      const int j8 = tid & 7;
      for (int ps = 0; ps < 4; ++ps) {
        const int rowl = ps * 32 + (tid >> 3);
        const int tok = m0 + rowl, s = sbase + rowl;
        const f32x4 v = *(const f32x4*)(Cs + rowl * 132 + j8 * 4);
        if (!lat) *(f32x4*)(p.out + O_KPE + ((size_t)(bb * 4 + l) * 256 + s) * 32 + j8 * 4) = v;
        *(f32x4*)(p.kpe + (size_t)tok * 32 + j8 * 4) = v;
      }
    }
    if (nt == 18 || nt == 19) {
      asm volatile("s_waitcnt vmcnt(0)" ::: "memory");
      __syncthreads();
      if (threadIdx.x == 0) {
        __builtin_amdgcn_fence(__ATOMIC_RELEASE, "agent");
        asm volatile("s_waitcnt vmcnt(0)" ::: "memory");
        xb_add(p.ctrl + CTRL_MLACNT(l, mt), 1u);
      }
    }
  }
}

DI s16x4 vtr(const u16* pp) { return __builtin_bit_cast(s16x4, __builtin_amdgcn_ds_read_tr16_b64_v4i16((LAS v4i16_t*)(pp))); }

template <int DQ>
DI void attn_run(const u16* qptr, int nt0, const u16* k0p, const u16* v0p, int nt1, const u16* k1p, const u16* v1p,
                 int mode, int kpos1, int qpos0, bool has_sink, float sink2, const float* rpb_g, u16* outp, char* smem) {
  constexpr int DQ16 = DQ / 16, KS = DQ + 8, NKR = DQ / 32, CPR = DQ / 8;
  constexpr int BUFE = 64 * KS + 64 * 72;
  u16* Ks0 = (u16*)smem; float* rpb_s = (float*)(Ks0 + 2 * BUFE);
  const int tid = tidx(), lane = tid & 63, wave = tid >> 6, r32 = lane & 31, hi = lane >> 5;
  __syncthreads();
  if (mode == 2) { for (int i = tid; i < 465; i += 256) rpb_s[i] = rpb_g[i] * LOG2E; }
  bf16x8 qf[DQ16];
  {
    const u16* qrow = qptr + (size_t)(wave * 32 + r32) * DQ + hi * 8;
#pragma unroll
    for (int d0 = 0; d0 < DQ16; ++d0) qf[d0] = *(const bf16x8*)(qrow + d0 * 16);
  }
  f32x16 o0, o1;
#pragma unroll
  for (int r = 0; r < 16; ++r) { o0[r] = 0.f; o1[r] = 0.f; }
  float m = 0.f, lsum = 0.f;
  f32x16 negm;
#pragma unroll
  for (int r = 0; r < 16; ++r) negm[r] = 0.f;
  const int ntot = nt0 + nt1;
  u32x4 kr[NKR], vr[2];
  auto issue = [&](int t) {
    const u16* kp = (t < nt0) ? (k0p + (size_t)t * 64 * DQ) : (k1p + (size_t)(t - nt0) * 64 * DQ);
    const u16* vp = (t < nt0) ? (v0p + (size_t)t * 64 * 64) : (v1p + (size_t)(t - nt0) * 64 * 64);
#pragma unroll
    for (int i = 0; i < NKR; ++i) kr[i] = *(const u32x4*)(kp + (size_t)(i * 256 + tid) * 8);
#pragma unroll
    for (int i = 0; i < 2; ++i) vr[i] = *(const u32x4*)(vp + (size_t)(i * 256 + tid) * 8);
  };
  auto stage = [&](int buf) {
    u16* Ks = Ks0 + buf * BUFE; u16* Vs = Ks + 64 * KS;
#pragma unroll
    for (int i = 0; i < NKR; ++i) { const int c = i * 256 + tid; const int row = c / CPR, col = c % CPR; *(u32x4*)(Ks + row * KS + col * 8) = kr[i]; }
#pragma unroll
    for (int i = 0; i < 2; ++i) { const int c = i * 256 + tid; const int row = c >> 3, col = c & 7; *(u32x4*)(Vs + row * 72 + col * 8) = vr[i]; }
  };
  issue(0);
  stage(0);
  if (ntot > 1) issue(1);
  __syncthreads();
  const int qpos = qpos0 + wave * 32 + r32;
  const int qr = qpos >> 6, qc = qpos & 63;
  int r0q = qr - 4; r0q = r0q < 0 ? 0 : (r0q > 24 ? 24 : r0q);
  int c0q = qc - 8; c0q = c0q < 0 ? 0 : (c0q > 48 ? 48 : c0q);
  const int vofs = 64 * KS + (4 * hi + ((lane & 15) >> 2)) * 72 + ((lane >> 4) & 1) * 16 + (lane & 3) * 4;
  for (int t = 0; t < ntot; ++t) {
    const u16* Ks = Ks0 + (t & 1) * BUFE;
    const u16* vbase = Ks + vofs;
    f32x16 p0 = negm, p1 = negm;
#pragma unroll
    for (int d0 = 0; d0 < DQ16; ++d0) {
      const bf16x8 ka = *(const bf16x8*)(Ks + r32 * KS + d0 * 16 + hi * 8);
      const bf16x8 kb = *(const bf16x8*)(Ks + (32 + r32) * KS + d0 * 16 + hi * 8);
      p0 = MFMA(ka, qf[d0], p0); p1 = MFMA(kb, qf[d0], p1);
    }
    if (t >= nt0 && mode != 0) {
      const int kt = t - nt0;
      if (mode == 1) {
        const int kb0 = kpos1 + kt * 64;
#pragma unroll
        for (int r = 0; r < 16; ++r) {
          const int kp = kb0 + crow(r, hi);
          int d = qpos - kp; d = d < 0 ? -d : d;
          if (d > 128) p0[r] = -1e30f;
          int d2 = qpos - (kp + 32); d2 = d2 < 0 ? -d2 : d2;
          if (d2 > 128) p1[r] = -1e30f;
        }
      } else {
        const int krow_ = kpos1 + kt;
        const bool rowok = (krow_ >= r0q) && (krow_ < r0q + 8);
        const int dr = krow_ - qr + 7;
#pragma unroll
        for (int r = 0; r < 16; ++r) {
          {
            const int kc = crow(r, hi);
            const bool ok = rowok && (kc >= c0q) && (kc < c0q + 16);
            int dc = kc - qc; dc = dc < -15 ? -15 : (dc > 15 ? 15 : dc);
            const int idx = ok ? (dr * 31 + dc + 15) : 0;
            const float bv = rpb_s[idx];
            p0[r] = ok ? p0[r] + bv : -1e30f;
          }
          {
            const int kc = 32 + crow(r, hi);
            const bool ok = rowok && (kc >= c0q) && (kc < c0q + 16);
            int dc = kc - qc; dc = dc < -15 ? -15 : (dc > 15 ? 15 : dc);
            const int idx = ok ? (dr * 31 + dc + 15) : 0;
            const float bv = rpb_s[idx];
            p1[r] = ok ? p1[r] + bv : -1e30f;
          }
        }
      }
    }
    float mxa = fmaxf(fmaxf(p0[0], p0[1]), p1[0]), mxb = fmaxf(fmaxf(p0[2], p0[3]), p1[1]);
    mxa = fmaxf(fmaxf(mxa, p1[2]), p1[3]);
#pragma unroll
    for (int r = 4; r < 16; r += 4) {
      mxa = fmaxf(fmaxf(mxa, p0[r]), p0[r + 1]); mxb = fmaxf(fmaxf(mxb, p0[r + 2]), p0[r + 3]);
      mxa = fmaxf(fmaxf(mxa, p1[r]), p1[r + 1]); mxb = fmaxf(fmaxf(mxb, p1[r + 2]), p1[r + 3]);
    }
    float mx = fmaxf(mxa, mxb);
    mx = fmaxf(mx, __shfl_xor(mx, 32));
    if (__builtin_amdgcn_ballot_w64(mx > 8.f) != 0ull) {
      const float d = (mx > 8.f) ? mx : 0.f;
      const float alpha = ex2(-d);
      m += d; lsum *= alpha;
#pragma unroll
      for (int r = 0; r < 16; ++r) { o0[r] *= alpha; o1[r] *= alpha; p0[r] -= d; p1[r] -= d; negm[r] = -m; }
    }
    float rs = 0.f;
#pragma unroll
    for (int r = 0; r < 16; ++r) { p0[r] = ex2(p0[r]); p1[r] = ex2(p1[r]); rs += p0[r] + p1[r]; }
    lsum += rs;
    if (t + 1 < ntot) { stage((t + 1) & 1); if (t + 2 < ntot) issue(t + 2); }
#pragma unroll
    for (int s = 0; s < 4; ++s) {
      u32x4 pw;
      if (s < 2) { pw[0] = pk2(p0[8 * s + 0], p0[8 * s + 1]); pw[1] = pk2(p0[8 * s + 2], p0[8 * s + 3]); pw[2] = pk2(p0[8 * s + 4], p0[8 * s + 5]); pw[3] = pk2(p0[8 * s + 6], p0[8 * s + 7]); }
      else { const int ss = s - 2; pw[0] = pk2(p1[8 * ss + 0], p1[8 * ss + 1]); pw[1] = pk2(p1[8 * ss + 2], p1[8 * ss + 3]); pw[2] = pk2(p1[8 * ss + 4], p1[8 * ss + 5]); pw[3] = pk2(p1[8 * ss + 6], p1[8 * ss + 7]); }
      const bf16x8 pf = __builtin_bit_cast(bf16x8, pw);
      const u16* vb = vbase + (16 * s) * 72;
      {
        const s16x4 lo = vtr(vb), hi4 = vtr(vb + 8 * 72);
        const bf16x8 vf = __builtin_shufflevector(lo, hi4, 0, 1, 2, 3, 4, 5, 6, 7);
        o0 = MFMA(vf, pf, o0);
      }
      {
        const s16x4 lo = vtr(vb + 32), hi4 = vtr(vb + 8 * 72 + 32);
        const bf16x8 vf = __builtin_shufflevector(lo, hi4, 0, 1, 2, 3, 4, 5, 6, 7);
        o1 = MFMA(vf, pf, o1);
      }
    }
    __syncthreads();
  }
  float lt = lsum + __shfl_xor(lsum, 32);
  if (has_sink) lt += ex2(sink2 - m);
  const float inv = 1.f / lt;
  u16* orow = outp + (size_t)(wave * 32 + r32) * 1024;
#pragma unroll
  for (int g = 0; g < 4; ++g) {
    u32x2 w0 = {pk2(o0[4 * g] * inv, o0[4 * g + 1] * inv), pk2(o0[4 * g + 2] * inv, o0[4 * g + 3] * inv)};
    *(u32x2*)(orow + 8 * g + 4 * hi) = w0;
    u32x2 w1 = {pk2(o1[4 * g] * inv, o1[4 * g + 1] * inv), pk2(o1[4 * g + 2] * inv, o1[4 * g + 3] * inv)};
    *(u32x2*)(orow + 32 + 8 * g + 4 * hi) = w1;
  }
}

DI void attn_item(const Params& p, int l, int item, char* smem) {
  int mix, lat, b, h, qt;
  if (item < 512) {
    const int g = item >> 7; mix = (g == 0) ? 3 : (g == 1) ? 1 : (g == 2) ? 0 : 2; lat = 1;
    const int i = item & 127; b = i >> 6; h = (i >> 4) & 3; qt = i & 15;
  } else {
    const int g = (item - 512) >> 7; mix = (g == 0) ? 3 : (g - 1); lat = 0;
    const int i = item & 127; b = i >> 3; h = (i >> 1) & 3; qt = i & 1;
  }
  const int tb = lat ? (NCTX + b * 2048) : (b * 256);
  const int q0 = qt * 128;
  const int hkv = (mix == 1 || mix == 2) ? (h >> 1) : h;
  const int HKV = (mix == 1 || mix == 2) ? 2 : 4;
  u16* outp = p.br + (size_t)(tb + q0) * 1024 + mix * 256 + h * 64;
  const bool has_sink = (mix == 2);
  const float sink2 = has_sink ? p.sink_c[l * 4 + h] * LOG2E : 0.f;
  const u16 *Q, *K, *V, *CK, *CV;
  if (mix == 0) { Q = p.QA; K = p.KA; V = p.VA; CK = p.CKA; CV = p.CVA; }
  else if (mix == 1) { Q = p.QB; K = p.KB; V = p.VB; CK = p.CKB; CV = p.CVB; }
  else if (mix == 2) { Q = p.QC; K = p.KC; V = p.VC; CK = p.CKC; CV = p.CVC; }
  else { Q = p.QD; K = p.KD; V = p.VD; CK = p.CKD; CV = p.CVD; }
  const int DQ = (mix == 3) ? 96 : 64;
  const u16* qptr = Q + ((size_t)h * NTOK + tb + q0) * DQ;
  const u16* kown = K + ((size_t)hkv * NTOK + tb) * DQ;
  const u16* vown = V + ((size_t)hkv * NTOK + tb) * 64;
  int nt0, nt1 = 0, mode = 0, kpos1 = 0;
  const u16 *k0p, *v0p, *k1p = kown, *v1p = vown;
  if (!lat) { nt0 = 4; k0p = kown; v0p = vown; }
  else {
    nt0 = 4;
    const size_t cs = ((size_t)(l * 2 + b) * HKV + hkv) * 256;
    k0p = CK + cs * DQ; v0p = CV + cs * 64;
    if (mix == 1 || mix == 3) { nt1 = 32; }
    else if (mix == 2) {
      int lo = q0 - 128; if (lo < 0) lo = 0; int hi_ = q0 + 256; if (hi_ > 2048) hi_ = 2048;
      nt1 = (hi_ - lo) >> 6; kpos1 = lo; mode = 1;
      k1p = kown + (size_t)lo * DQ; v1p = vown + (size_t)lo * 64;
    } else {
      const int R = qt * 2;
      int ra = R - 4; ra = ra < 0 ? 0 : (ra > 24 ? 24 : ra);
      int rb = R + 1 - 4; rb = rb < 0 ? 0 : (rb > 24 ? 24 : rb);
      nt1 = rb + 8 - ra; kpos1 = ra; mode = 2;
      k1p = kown + (size_t)ra * 64 * DQ; v1p = vown + (size_t)ra * 64 * 64;
    }
  }
  const float* rpb_g = p.rpb_a + ((size_t)l * 4 + h) * 465;
  if (mix == 3) attn_run<96>(qptr, nt0, k0p, v0p, nt1, k1p, v1p, mode, kpos1, q0, has_sink, sink2, rpb_g, outp, smem);
  else attn_run<64>(qptr, nt0, k0p, v0p, nt1, k1p, v1p, mode, kpos1, q0, has_sink, sink2, rpb_g, outp, smem);
}

DI void phase_attn(const Params& p, int l, char* smem, LAS unsigned* s_item) {
  unsigned* ctr = p.ctrl + CTRL_QUEUE(l);
  for (;;) {
    __syncthreads();
    if (tidx() == 0) *s_item = atomicAdd(ctr, 1u);
    __syncthreads();
    const int item = (int)*s_item;
    if (item >= 1024) break;
    attn_item(p, l, item, smem);
  }
}

DI void phase_merge(const Params& p, int l, char* smem) {
  const u16* W = p.Wt_br + (size_t)l * DM * DM;
  u16* S = (u16*)smem;
  for (int t = blockIdx.x; t < 512; t += gridDim.x) {
    const int mt = t & 63, nt = t >> 6;
    const int m0 = mt * 128, n0 = nt * 128;
    const int tid = tidx(), lane = tid & 63, wave = tid >> 6, r32 = lane & 31, hi = lane >> 5, wm = wave >> 1, wn = wave & 1;
    const int lr = tid >> 3, lc = (tid & 7) * 8;
    const u16* ap = p.br + (size_t)(m0 + lr) * 1024 + lc;
    const u16* bp = W + (size_t)(n0 + lr) * DM + lc;
    f32x16 tot[2][2], acc[2][2]; zero_acc(tot); zero_acc(acc);
    u32x4 ra[4], rb[4];
    __syncthreads();
#pragma unroll
    for (int i = 0; i < 4; ++i) { ra[i] = *(const u32x4*)(ap + (size_t)i * 32 * 1024); rb[i] = *(const u32x4*)(bp + (size_t)i * 32 * DM); }
#pragma unroll 1
    for (int n = 0; n < 4; ++n) {
#pragma unroll
      for (int kq = 0; kq < 4; ++kq) {
        const int kt = n * 4 + kq, cur = kq & 1;
        {
          u16* As_ = S + cur * 2 * STG + lr * LDS_LD + lc; u16* Bs_ = As_ + STG;
#pragma unroll
          for (int i = 0; i < 4; ++i) { *(u32x4*)(As_ + i * 32 * LDS_LD) = ra[i]; *(u32x4*)(Bs_ + i * 32 * LDS_LD) = rb[i]; }
        }
        __syncthreads();
        {
          const int kn = (kt + 1 < 16) ? kt + 1 : 15;
#pragma unroll
          for (int i = 0; i < 4; ++i) { ra[i] = *(const u32x4*)(ap + (size_t)i * 32 * 1024 + kn * 64); rb[i] = *(const u32x4*)(bp + (size_t)i * 32 * DM + kn * 64); }
        }
        const u16* As_ = S + cur * 2 * STG; const u16* Bs_ = As_ + STG;
#pragma unroll
        for (int ks = 0; ks < 4; ++ks) {
          const bf16x8 a0 = *(const bf16x8*)(As_ + (wm * 64 + r32) * LDS_LD + ks * 16 + hi * 8);
          const bf16x8 a1 = *(const bf16x8*)(As_ + (wm * 64 + 32 + r32) * LDS_LD + ks * 16 + hi * 8);
          const bf16x8 b0 = *(const bf16x8*)(Bs_ + (wn * 64 + r32) * LDS_LD + ks * 16 + hi * 8);
          const bf16x8 b1 = *(const bf16x8*)(Bs_ + (wn * 64 + 32 + r32) * LDS_LD + ks * 16 + hi * 8);
          acc[0][0] = MFMA(b0, a0, acc[0][0]); acc[0][1] = MFMA(b1, a0, acc[0][1]);
          acc[1][0] = MFMA(b0, a1, acc[1][0]); acc[1][1] = MFMA(b1, a1, acc[1][1]);
        }
      }
      int gofs = (m0 + wm * 64 + r32) * 4096 + n * 1024 + n0 + wn * 64 + 4 * hi;
      asm volatile("" : "+v"(gofs));
      const u16* gb = p.gates;
#pragma unroll
      for (int i = 0; i < 2; ++i)
#pragma unroll
        for (int j = 0; j < 2; ++j) {
          asm volatile("" ::: "memory");
#pragma unroll
          for (int g = 0; g < 4; ++g) {
            const u32x2 gw = *(const u32x2*)(gb + gofs + i * 32 * 4096 + j * 32 + 8 * g);
            tot[i][j][4 * g + 0] += bf_lo(gw[0]) * acc[i][j][4 * g + 0];
            tot[i][j][4 * g + 1] += bf_hi(gw[0]) * acc[i][j][4 * g + 1];
            tot[i][j][4 * g + 2] += bf_lo(gw[1]) * acc[i][j][4 * g + 2];
            tot[i][j][4 * g + 3] += bf_hi(gw[1]) * acc[i][j][4 * g + 3];
            acc[i][j][4 * g + 0] = 0.f; acc[i][j][4 * g + 1] = 0.f; acc[i][j][4 * g + 2] = 0.f; acc[i][j][4 * g + 3] = 0.f;
          }
        }
    }
#pragma unroll
    for (int i = 0; i < 2; ++i)
#pragma unroll
      for (int j = 0; j < 2; ++j) {
        u16* q = p.merged + (size_t)(m0 + wm * 64 + i * 32 + r32) * DM + n0 + wn * 64 + j * 32 + 4 * hi;
#pragma unroll
        for (int g = 0; g < 4; ++g) {
          u32x2 w = {pk2(tot[i][j][4 * g], tot[i][j][4 * g + 1]), pk2(tot[i][j][4 * g + 2], tot[i][j][4 * g + 3])};
          *(u32x2*)(q + 8 * g) = w;
        }
      }
  }
}

DI void phase_outproj(const Params& p, int l, char* smem) {
  const u16* W = p.Wt_out + (size_t)l * DM * DM;
  for (int t = blockIdx.x; t < 512; t += gridDim.x) {
    const int mt = t & 63, nt = t >> 6;
    const int m0 = mt * 128, n0 = nt * 128;
    f32x16 acc[2][2]; zero_acc(acc);
    gemm2(acc, p.merged + (size_t)m0 * DM, DM, W + (size_t)n0 * DM, DM, DM, smem);
    const float* mod = p.mod + ((size_t)l * 3 + cond_of_row(m0)) * 6144;
    const float* xin = (l == 0) ? ((m0 < NCTX) ? (p.x_prompt + (size_t)m0 * DM) : (p.x_sample + (size_t)(m0 - NCTX) * DM)) : (p.out + (size_t)m0 * DM);
    epi_residual(acc, p.out, xin, mod + 2048, m0, n0);
  }
}

struct ConvW { f32x4 wa0, wa1, wa2, wg0, wg1, wg2, ba, bg; };
DI ConvW conv_load(const float* cw, const float* cb, int ca_col) {
  ConvW w;
  w.wa0 = *(const f32x4*)(cw + ca_col); w.wa1 = *(const f32x4*)(cw + UPC + ca_col); w.wa2 = *(const f32x4*)(cw + 2 * UPC + ca_col);
  w.wg0 = *(const f32x4*)(cw + DFF + ca_col); w.wg1 = *(const f32x4*)(cw + UPC + DFF + ca_col); w.wg2 = *(const f32x4*)(cw + 2 * UPC + DFF + ca_col);
  w.ba = *(const f32x4*)(cb + ca_col); w.bg = *(const f32x4*)(cb + DFF + ca_col);
  return w;
}
DI void conv_act4(const f32x4& ua, const f32x4& ca, const f32x4& da, const f32x4& ug, const f32x4& cg, const f32x4& dg, const ConvW& w, u16* dst) {
  float o[4];
#pragma unroll
  for (int e = 0; e < 4; ++e) {
    const float a = w.ba[e] + w.wa0[e] * ua[e] + w.wa1[e] * ca[e] + w.wa2[e] * da[e];
    const float g = w.bg[e] + w.wg0[e] * ug[e] + w.wg1[e] * cg[e] + w.wg2[e] * dg[e];
    o[e] = siluf_(g) * a;
  }
  u32x2 pk = {pk2(o[0], o[1]), pk2(o[2], o[3])};
  *(u32x2*)dst = pk;
}

DI void phase_up(const Params& p, int l, char* smem) {
  const u16* W = p.Wt_up + (size_t)l * UPC * DM;
  const float* cw = p.conv_w + (size_t)l * 3 * UPC;
  const float* cb = p.conv_b + (size_t)l * UPC;
  float* Cs = (float*)smem;
  const int NT = 64 * 44;
  G2Regs R; G2Ptrs P;
  const size_t bex = (size_t)(DFF - 64) * DM;
  if ((int)blockIdx.x < NT) { const int t0 = blockIdx.x; P = g2_ptrs(p.h + (size_t)(t0 & 63) * 128 * DM, DM, W + (size_t)(t0 >> 6) * 64 * DM, DM, bex); g2_prefetch(R, P); }
  for (int t = blockIdx.x; t < NT; t += gridDim.x) {
    const int mt = t & 63, nt = t >> 6;
    const int m0 = mt * 128, n0 = nt * 64;
    f32x16 acc[2][2]; zero_acc(acc);
    g2_main(acc, R, P, DM, smem);
    {
      const int tn = t + gridDim.x;
      if (tn < NT) { P = g2_ptrs(p.h + (size_t)(tn & 63) * 128 * DM, DM, W + (size_t)(tn >> 6) * 64 * DM, DM, bex); g2_prefetch(R, P); }
    }
    const int tid = tidx(), lane = tid & 63, wave = tid >> 6, r32 = lane & 31, hi = lane >> 5, wm = wave >> 1, wn = wave & 1;
#pragma unroll
    for (int i = 0; i < 2; ++i)
#pragma unroll
      for (int j = 0; j < 2; ++j)
#pragma unroll
        for (int g = 0; g < 4; ++g) {
          f32x4 v = {acc[i][j][4 * g], acc[i][j][4 * g + 1], acc[i][j][4 * g + 2], acc[i][j][4 * g + 3]};
          *(f32x4*)(Cs + (wm * 64 + i * 32 + r32) * 132 + wn * 64 + j * 32 + 8 * g + 4 * hi) = v;
        }
    __syncthreads();
    const int T = (m0 < NCTX) ? 256 : 2048;
    const int s0 = (m0 < NCTX) ? (m0 & 255) : ((m0 - NCTX) & 2047);
    const bool first = (s0 == 0), last = (s0 + 128 == T);
    const int c4 = (tid & 15) * 4;
    const f32x4 z4 = {0.f, 0.f, 0.f, 0.f};
    const ConvW cwt = conv_load(cw, cb, n0 + c4);
#pragma unroll 2
    for (int k = 0; k < 8; ++k) {
      const int row = (tid >> 4) + 16 * k;
      if ((row == 0 && !first) || (row == 127 && !last)) continue;
      const float* cr = Cs + row * 132 + c4;
      const f32x4 ca = *(const f32x4*)cr, cg = *(const f32x4*)(cr + 64);
      f32x4 ua = z4, ug = z4, da = z4, dg = z4;
      if (row > 0) { ua = *(const f32x4*)(cr - 132); ug = *(const f32x4*)(cr - 132 + 64); }
      if (row < 127) { da = *(const f32x4*)(cr + 132); dg = *(const f32x4*)(cr + 132 + 64); }
      conv_act4(ua, ca, da, ug, cg, dg, cwt, p.act + (size_t)(m0 + row) * DFF + n0 + c4);
    }
    if (tid < 128) {
      const int gc = (tid < 64) ? (n0 + tid) : (DFF + n0 + tid - 64);
      float* ubp = p.ub + (size_t)mt * 4 * UPC + gc;
      ubp[0] = Cs[0 * 132 + tid]; ubp[UPC] = Cs[1 * 132 + tid]; ubp[2 * UPC] = Cs[126 * 132 + tid]; ubp[3 * UPC] = Cs[127 * 132 + tid];
    }
  }
}

DI void phase_down(const Params& p, int l, char* smem) {
  const u16* W = p.Wt_down + (size_t)l * DM * DFF;
  const float* cw = p.conv_w + (size_t)l * 3 * UPC;
  const float* cb = p.conv_b + (size_t)l * UPC;
  for (int t = blockIdx.x; t < 512; t += gridDim.x) {
    const int mt = t & 63, nt = t >> 6;
    const int m0 = mt * 128, n0 = nt * 128;
    {
      const int tid = tidx();
      const int T = (m0 < NCTX) ? 256 : 2048;
      const int s0 = (m0 < NCTX) ? (m0 & 255) : ((m0 - NCTX) & 2047);
      const bool first = (s0 == 0), last = (s0 + 128 == T);
      for (int idx = tid; idx < 2 * 704; idx += 256) {
        const int rsel = idx / 704, c4 = (idx % 704) * 4;
        if ((rsel == 0 && first) || (rsel == 1 && last)) continue;
        const float* u_up = rsel ? (p.ub + ((size_t)mt * 4 + 2) * UPC) : (p.ub + ((size_t)(mt - 1) * 4 + 3) * UPC);
        const float* u_cu = rsel ? (p.ub + ((size_t)mt * 4 + 3) * UPC) : (p.ub + ((size_t)mt * 4 + 0) * UPC);
        const float* u_dn = rsel ? (p.ub + ((size_t)(mt + 1) * 4 + 0) * UPC) : (p.ub + ((size_t)mt * 4 + 1) * UPC);
        const f32x4 ua = *(const f32x4*)(u_up + c4), ca = *(const f32x4*)(u_cu + c4), da = *(const f32x4*)(u_dn + c4);
        const f32x4 ug = *(const f32x4*)(u_up + DFF + c4), cg = *(const f32x4*)(u_cu + DFF + c4), dg = *(const f32x4*)(u_dn + DFF + c4);
        const ConvW cwt = conv_load(cw, cb, c4);
        conv_act4(ua, ca, da, ug, cg, dg, cwt, p.act + (size_t)(m0 + (rsel ? 127 : 0)) * DFF + c4);
      }
      asm volatile("s_waitcnt vmcnt(0)" ::: "memory");
    }
    f32x16 acc[2][2]; zero_acc(acc);
    gemm2(acc, p.act + (size_t)m0 * DFF, DFF, W + (size_t)n0 * DFF, DFF, DFF, smem);
    const float* mod = p.mod + ((size_t)l * 3 + cond_of_row(m0)) * 6144;
    epi_residual(acc, p.out, p.out + (size_t)m0 * DM, mod + 5120, m0, n0);
  }
}

DI void phase_prologue(const Params& p, char* smem) {
  const int tid = tidx(), lane = tid & 63, wave = tid >> 6;
  for (int item = blockIdx.x; item < 384; item += gridDim.x) {
    {
      const int l = item / 96, cg = item % 96;
      float* sc = (float*)smem;
      float* red = sc + 3072;
      __syncthreads();
      for (int i = tid; i < 3072; i += 256) {
        const int c = i >> 10, k = i & 1023;
        const float v = (c == 0) ? p.c_ctx[k] : p.c[(c - 1) * 1024 + k];
        sc[i] = siluf_(v);
      }
      __syncthreads();
      const int cl = tid & 15, kg = tid >> 4;
      const float* w = p.w_ada + ((size_t)l * 1024 + kg * 64) * 6144 + cg * 64 + cl * 4;
      f32x4 a0 = {0, 0, 0, 0}, a1 = {0, 0, 0, 0}, a2 = {0, 0, 0, 0};
#pragma unroll 16
      for (int k = 0; k < 64; ++k) {
        const f32x4 wv = __builtin_nontemporal_load((const f32x4*)(w + (size_t)k * 6144));
        const float s0 = sc[kg * 64 + k], s1 = sc[1024 + kg * 64 + k], s2 = sc[2048 + kg * 64 + k];
#pragma unroll
        for (int e = 0; e < 4; ++e) { a0[e] += s0 * wv[e]; a1[e] += s1 * wv[e]; a2[e] += s2 * wv[e]; }
      }
      *(f32x4*)(red + (kg * 3 + 0) * 64 + cl * 4) = a0;
      *(f32x4*)(red + (kg * 3 + 1) * 64 + cl * 4) = a1;
      *(f32x4*)(red + (kg * 3 + 2) * 64 + cl * 4) = a2;
      __syncthreads();
      if (tid < 192) {
        const int c = tid >> 6, col = tid & 63;
        float s = 0.f;
#pragma unroll
        for (int g = 0; g < 16; ++g) s += red[(g * 3 + c) * 64 + col];
        const int cc = cg * 64 + col;
        p.mod[((size_t)l * 3 + c) * 6144 + cc] = s + p.b_ada[(size_t)l * 6144 + cc];
      }
    }
  }
  for (int i = blockIdx.x * 256 + tid; i < 2 * 4 * 256 * 128 / 8; i += gridDim.x * 256) {
    const f32x4 v0 = *(const f32x4*)(p.c_mla_ckv + (size_t)i * 8), v1 = *(const f32x4*)(p.c_mla_ckv + (size_t)i * 8 + 4);
    u32x4 o = {pk2(v0[0], v0[1]), pk2(v0[2], v0[3]), pk2(v1[0], v1[1]), pk2(v1[2], v1[3])};
    *(u32x4*)(p.cckv + (size_t)i * 8) = o;
  }
  {
    float* T = (float*)smem;
    for (int t = blockIdx.x; t < 4 * 4256; t += gridDim.x) {
      const int l = t / 4256; int r = t % 4256;
      const float* W; u16* D; int K, N, kt, nt;
      bool isin = false;
      if (r < 1616) { W = p.w_in + (size_t)l * DM * INC; D = p.Wt_in + (size_t)l * INP * DM; K = DM; N = INC; nt = r % 101; kt = r / 101; isin = true; }
      else if ((r -= 1616) < 1408) { W = p.w_up + (size_t)l * DM * UPC; D = p.Wt_up + (size_t)l * UPC * DM; K = DM; N = UPC; nt = r % 88; kt = r / 88; }
      else if ((r -= 1408) < 704) { W = p.w_down + (size_t)l * DFF * DM; D = p.Wt_down + (size_t)l * DM * DFF; K = DFF; N = DM; nt = r & 15; kt = r >> 4; }
      else if ((r -= 704) < 256) { W = p.w_out + (size_t)l * DM * DM; D = p.Wt_out + (size_t)l * DM * DM; K = DM; N = DM; nt = r & 15; kt = r >> 4; }
      else if ((r -= 256) < 256) { W = p.w_branch + (size_t)l * DM * DM; D = p.Wt_br + (size_t)l * DM * DM; K = DM; N = DM; nt = r & 15; kt = r >> 4; }
      else { r -= 256; W = p.w_ukv + (size_t)l * 128 * 512; D = p.Wt_ukv + (size_t)l * 512 * 128; K = 128; N = 512; nt = r & 7; kt = r >> 3; }
      const int k0 = kt * 64, n0 = nt * 64;
      __syncthreads();
      {
        const int c4 = (tid & 15) * 4, rr = tid >> 4;
        const bool ok = (n0 + c4) < N;
#pragma unroll
        for (int i = 0; i < 4; ++i) {
          f32x4 v = {0.f, 0.f, 0.f, 0.f};
          if (ok) v = __builtin_nontemporal_load((const f32x4*)(W + (size_t)(k0 + i * 16 + rr) * N + n0 + c4));
          float* tp = T + (i * 16 + rr) * 65 + c4;
          tp[0] = v[0]; tp[1] = v[1]; tp[2] = v[2]; tp[3] = v[3];
        }
      }
      __syncthreads();
      {
        const int kc = (tid & 7) * 8;
#pragma unroll
        for (int ps = 0; ps < 2; ++ps) {
          const int n = ps * 32 + (tid >> 3);
          if (n0 + n < N) {
            const float* tp = T + kc * 65 + n;
            u32x4 o = {pk2(tp[0], tp[65]), pk2(tp[2 * 65], tp[3 * 65]), pk2(tp[4 * 65], tp[5 * 65]), pk2(tp[6 * 65], tp[7 * 65])};
            const int drow = isin ? virt_col(n0 + n) : (n0 + n);
            *(u32x4*)(D + (size_t)drow * K + k0 + kc) = o;
          }
        }
      }
    }
  }
  const int gt = blockIdx.x * 256 + tid, gs = gridDim.x * 256;
  for (int it = gt; it < 2 * 65536 + 4 * 32768; it += gs) {
    const float* src; u16* dst; int H, i;
    if (it < 65536) { src = p.c_nat_k; dst = p.CKA; H = 4; i = it; }
    else if (it < 131072) { src = p.c_nat_v; dst = p.CVA; H = 4; i = it - 65536; }
    else {
      const int j = it - 131072; const int w = j >> 15; i = j & 32767; H = 2;
      src = (w == 0) ? p.c_gqa_k : (w == 1) ? p.c_gqa_v : (w == 2) ? p.c_win_k : p.c_win_v;
      dst = (w == 0) ? p.CKB : (w == 1) ? p.CVB : (w == 2) ? p.CKC : p.CVC;
    }
    const int d8 = i & 7, s = (i >> 3) & 255;
    int rest = i >> 11; const int h = rest % H; rest /= H; const int b = rest & 1, l = rest >> 1;
    const float* sp = src + (((size_t)(b * 4 + l) * 256 + s) * H + h) * 64 + d8 * 8;
    const f32x4 v0 = *(const f32x4*)sp, v1 = *(const f32x4*)(sp + 4);
    u32x4 o = {pk2(v0[0], v0[1]), pk2(v0[2], v0[3]), pk2(v1[0], v1[1]), pk2(v1[2], v1[3])};
    *(u32x4*)(dst + ((((size_t)(l * 2 + b) * H + h) * 256 + s) * 64 + d8 * 8)) = o;
  }
  for (int i = gt; i < 1536; i += gs) {
    if (i < 1024) {
      const int pos = i >> 4, f = i & 15;
      const float inv = exp2f(-13.287712379549449f * (float)(2 * f) / 32.f);
      const float ang = (float)pos * inv;
      p.tabs[i] = cosf(ang); p.tabs[1024 + i] = sinf(ang);
    } else {
      const int j = i - 1024; const int pos = j >> 3, f = j & 7;
      const float inv = exp2f(-13.287712379549449f * (float)(2 * f) / 16.f);
      const float ang = (float)pos * inv;
      p.tabs[2048 + j] = cosf(ang); p.tabs[2560 + j] = sinf(ang);
    }
  }
}

__global__ void __launch_bounds__(256, 2) mega_kernel(Params p, int ph_lo, int ph_hi) {
  __shared__ __attribute__((aligned(16))) char smem[SMEM_BYTES];
  __shared__ uint4 xb_words;
  __shared__ unsigned s_item_w[4];
  if (tidx() == 0) xb_words = make_uint4(0u, 0u, 0u, 0u);
  __syncthreads();
  XcdBarrier bar; bar.bar = p.ctrl; bar.x = 0; bar.st = (volatile LAS unsigned*)&xb_words;
  if (ph_hi - ph_lo > 1) bar = xcd_barrier_post(p.ctrl, (volatile LAS unsigned*)&xb_words);
  for (int ph = ph_lo; ph < ph_hi; ++ph) {
    if (ph == 0) phase_prologue(p, smem);
    else {
      const int l = (ph - 1) / 8, s = (ph - 1) % 8;
      switch (s) {
        case 0: phase_norm(p, l, 0); break;
        case 1: phase_g1(p, l, smem); break;
        case 2: phase_attn(p, l, smem, (LAS unsigned*)s_item_w); break;
        case 3: phase_merge(p, l, smem); break;
        case 4: phase_outproj(p, l, smem); break;
        case 5: phase_norm(p, l, 1); break;
        case 6: phase_up(p, l, smem); break;
        default: phase_down(p, l, smem); break;
      }
    }
    if (ph + 1 < ph_hi) xcd_barrier(bar);
  }
}

static inline size_t align_up(size_t x) { return (x + 255) & ~(size_t)255; }

extern "C" void kernel_launch(void* const* d_in, const int* in_sizes, int n_in, void* d_out, int out_size, void* d_ws, size_t ws_size,
                              hipStream_t stream) {
  Params p{};
  const float** fp = (const float**)&p;
  for (int i = 0; i < 35; ++i) fp[i] = (const float*)d_in[i];
  p.out = (float*)d_out;
  char* w = (char*)d_ws; size_t off = 0;
  auto take = [&](size_t bytes) { void* r = w + off; off = align_up(off + bytes); return r; };
  p.ctrl = (unsigned*)take(CTRL_WORDS * 4);
  p.mod = (float*)take((size_t)4 * 3 * 6144 * 4);
  p.tabs = (float*)take(3072 * 4);
  {
    void* ur = take((size_t)NTOK * UPC * 2);
    p.proj = (float*)ur; p.u = (u16*)ur; p.ub = (float*)ur;
  }
  p.gates = (u16*)take((size_t)NTOK * 4096 * 2);
  p.QA = (u16*)take((size_t)4 * NTOK * 64 * 2); p.KA = (u16*)take((size_t)4 * NTOK * 64 * 2); p.VA = (u16*)take((size_t)4 * NTOK * 64 * 2);
  p.QB = (u16*)take((size_t)4 * NTOK * 64 * 2); p.KB = (u16*)take((size_t)2 * NTOK * 64 * 2); p.VB = (u16*)take((size_t)2 * NTOK * 64 * 2);
  p.QC = (u16*)take((size_t)4 * NTOK * 64 * 2); p.KC = (u16*)take((size_t)2 * NTOK * 64 * 2); p.VC = (u16*)take((size_t)2 * NTOK * 64 * 2);
  p.QD = (u16*)take((size_t)4 * NTOK * 96 * 2); p.KD = (u16*)take((size_t)4 * NTOK * 96 * 2); p.VD = (u16*)take((size_t)4 * NTOK * 64 * 2);
  p.act = p.QA;
  p.ckvn = (u16*)take((size_t)NTOK * 128 * 2);
  p.br = (u16*)take((size_t)NTOK * 1024 * 2);
  p.merged = (u16*)take((size_t)NTOK * 1024 * 2);
  p.h = p.merged;
  p.CKA = (u16*)take((size_t)4 * 2 * 4 * 256 * 64 * 2); p.CVA = (u16*)take((size_t)4 * 2 * 4 * 256 * 64 * 2);
  p.CKB = (u16*)take((size_t)4 * 2 * 2 * 256 * 64 * 2); p.CVB = (u16*)take((size_t)4 * 2 * 2 * 256 * 64 * 2);
  p.CKC = (u16*)take((size_t)4 * 2 * 2 * 256 * 64 * 2); p.CVC = (u16*)take((size_t)4 * 2 * 2 * 256 * 64 * 2);
  p.CKD = (u16*)take((size_t)4 * 2 * 4 * 256 * 96 * 2); p.CVD = (u16*)take((size_t)4 * 2 * 4 * 256 * 64 * 2);
  p.cckv = (u16*)take((size_t)2 * 4 * 256 * 128 * 2);
  p.kpe = (float*)take((size_t)NTOK * 32 * 4);
  p.Wt_in = (u16*)take((size_t)4 * INP * DM * 2);
  p.Wt_up = (u16*)take((size_t)4 * UPC * DM * 2);
  p.Wt_down = (u16*)take((size_t)4 * DM * DFF * 2);
  p.Wt_out = (u16*)take((size_t)4 * DM * DM * 2);
  p.Wt_br = (u16*)take((size_t)4 * DM * DM * 2);
  p.Wt_ukv = (u16*)take((size_t)4 * 512 * 128 * 2);
  if (off > ws_size) fprintf(stderr, "workspace too small: need %zu have %zu\n", off, ws_size);

  static int grid_blocks = 0;
  if (!grid_blocks) {
    int dev = 0, cus = 0, per_cu = 0;
    hipGetDevice(&dev);
    hipDeviceGetAttribute(&cus, hipDeviceAttributeMultiprocessorCount, dev);
    hipOccupancyMaxActiveBlocksPerMultiprocessor(&per_cu, mega_kernel, 256, 0);
    if (per_cu > 2) per_cu = 2;
    if (per_cu < 1) per_cu = 1;
    grid_blocks = cus * per_cu;
  }
  hipMemsetAsync(p.ctrl, 0, CTRL_WORDS * 4, stream);
#if SINGLE_LAUNCH
  int lo = 0, hi = NPHASE;
  void* args[] = {&p, &lo, &hi};
  hipError_t e = hipLaunchCooperativeKernel((void*)mega_kernel, dim3(grid_blocks), dim3(256), args, 0, stream);
  if (e != hipSuccess) fprintf(stderr, "cooperative launch failed: %s (grid %d)\n", hipGetErrorString(e), grid_blocks);
#else
  for (int ph = 0; ph < NPHASE; ++ph) mega_kernel<<<grid_blocks, 256, 0, stream>>>(p, ph, ph + 1);
#endif
}
```

```cpp
#include <hip/hip_runtime.h>
#include <stdint.h>
#include <stdio.h>

#ifndef SINGLE_LAUNCH
#define SINGLE_LAUNCH 1
#endif

typedef unsigned short u16;
typedef short bf16x8 __attribute__((ext_vector_type(8)));
typedef short s16x4 __attribute__((ext_vector_type(4)));
typedef float f32x16 __attribute__((ext_vector_type(16)));
typedef float f32x4 __attribute__((ext_vector_type(4)));
typedef unsigned u32x4 __attribute__((ext_vector_type(4)));
typedef unsigned u32x2 __attribute__((ext_vector_type(2)));
typedef __bf16 bf2_t __attribute__((ext_vector_type(2)));
typedef float f2_t __attribute__((ext_vector_type(2)));
typedef short v4i16_t __attribute__((ext_vector_type(4)));

#define DI __device__ __forceinline__
#define MFMA(a, b, c) __builtin_amdgcn_mfma_f32_32x32x16_bf16((a), (b), (c), 0, 0, 0)
#define LAS __attribute__((address_space(3)))

DI unsigned pk2(float a, float b) { f2_t v = {a, b}; return __builtin_bit_cast(unsigned, __builtin_convertvector(v, bf2_t)); }
DI float bf_lo(unsigned u) { return __uint_as_float(u << 16); }
DI float bf_hi(unsigned u) { return __uint_as_float(u & 0xffff0000u); }
DI int crow(int r, int hi) { return (r & 3) + 8 * (r >> 2) + 4 * hi; }
DI float ex2(float x) { return __builtin_amdgcn_exp2f(x); }
constexpr float LOG2E_ = 1.4426950408889634f;
DI float sigmoidf_(float x) { return __builtin_amdgcn_rcpf(1.f + ex2(-LOG2E_ * x)); }
DI float siluf_(float x) { return x * __builtin_amdgcn_rcpf(1.f + ex2(-LOG2E_ * x)); }
DI int tidx() { int t = threadIdx.x; asm volatile("" : "+v"(t)); return t; }

constexpr int NTOK = 8192, NCTX = 4096, DM = 1024, INC = 6432, PROJC = 2336, DFF = 2816, UPC = 5632, DEPTH = 4;
constexpr float EPS = 1e-6f;
constexpr float LOG2E = 1.4426950408889634f;
constexpr float QS64 = 0.125f * LOG2E;
constexpr float QS96 = 0.10206207261596575f * LOG2E;
constexpr int NPHASE = 1 + 8 * DEPTH;
constexpr int SMEM_BYTES = 73728;
constexpr int INP = 6656;

constexpr size_t O_X = 0, O_NATK = 8388608, O_NATV = 12582912, O_GQAK = 16777216, O_GQAV = 18874368,
                 O_WINK = 20971520, O_WINV = 23068672, O_CKV = 25165824, O_KPE = 27262976;

struct Params {
  const float *x_prompt, *x_sample, *c_nat_k, *c_nat_v, *c_gqa_k, *c_gqa_v, *c_win_k, *c_win_v, *c_mla_ckv, *c_mla_kpe;
  const float *c, *c_ctx, *w_ada, *b_ada, *norm1, *norm2, *w_in, *qn_a, *kn_a, *rpb_a, *qn_b, *kn_b, *qn_c, *kn_c, *sink_c;
  const float *qn_d, *kn_d, *kvn_d, *w_ukv, *w_branch, *w_out, *w_up, *conv_w, *conv_b, *w_down;
  float* out;
  unsigned* ctrl;
  float* mod;
  float* tabs;
  float* proj;
  u16* gates;
  u16 *QA, *KA, *VA, *QB, *KB, *VB, *QC, *KC, *VC, *QD, *KD, *VD;
  u16* ckvn;
  u16* br;
  u16* merged;
  u16* u;
  u16* act;
  u16 *CKA, *CVA, *CKB, *CVB, *CKC, *CVC, *CKD, *CVD;
  u16 *Wt_in, *Wt_up, *Wt_down, *Wt_out, *Wt_br, *Wt_ukv;
  float* ub;
  float* kpe;
  u16* cckv;
  u16* h;
};

#define XB_TMO      128
#define XB_XCNT(j)  (256  + 64 * (j))
#define XB_XSUB(j)  (1280 + 64 * (j))
#define XB_XGEN(j)  (2304 + 64 * (j))
#define XB_TOP      3328
#define XB_TOPGEN   3392
#define XCD_BAR_WORDS 3456
#define CTRL_QUEUE(l) (3520 + 64 * (l))
#define CTRL_WORDS 4096
#define XB_SPIN_CAP (1u << 22)
DI unsigned xb_ld(unsigned* p) { return __hip_atomic_load(p, __ATOMIC_RELAXED, __HIP_MEMORY_SCOPE_AGENT); }
DI unsigned xb_add(unsigned* p, unsigned v) { return __hip_atomic_fetch_add(p, v, __ATOMIC_RELAXED, __HIP_MEMORY_SCOPE_AGENT); }
DI unsigned xb_xcc_id() { return (unsigned)__builtin_amdgcn_s_getreg((3 << 11) | 20) & 0xFu; }
#define XB_SPIN(cond, bar) do { unsigned _sp = 0; while (cond) { __builtin_amdgcn_s_sleep(1); \
    if ((++_sp & 255u) == 0u) { if (xb_ld(&(bar)[XB_TMO])) break; if (_sp > XB_SPIN_CAP) { atomicAdd(&(bar)[XB_TMO], 1u); break; } } } } while (0)
struct XcdBarrier { unsigned* bar; unsigned x; volatile LAS unsigned* st; };
DI XcdBarrier xcd_barrier_post(unsigned* bar, volatile LAS unsigned* st) {
  XcdBarrier b; b.bar = bar; b.x = xb_xcc_id(); b.st = st;
  if (threadIdx.x == 0) (void)xb_add(&bar[XB_XCNT(b.x)], 1u);
  return b;
}
DI void xcd_barrier_complete(unsigned* bar, unsigned x, unsigned& nloc, unsigned& nx) {
  const unsigned G = gridDim.x * gridDim.y * gridDim.z;
  unsigned sum, cnt, mine, sp = 0u;
  for (;;) {
    sum = 0u; cnt = 0u; mine = 0u;
#pragma unroll
    for (unsigned j = 0; j < 16; ++j) { const unsigned c = xb_ld(&bar[XB_XCNT(j)]); sum += c; cnt += (c > 0u) ? 1u : 0u; mine = (j == x) ? c : mine; }
    if (sum == G) break;
    __builtin_amdgcn_s_sleep(1);
    if ((++sp & 255u) == 0u) { if (xb_ld(&bar[XB_TMO])) break; if (sp > XB_SPIN_CAP) { atomicAdd(&bar[XB_TMO], 1u); break; } }
  }
  nloc = mine > 0u ? mine : 1u; nx = cnt > 0u ? cnt : 1u;
}
DI void xcd_barrier(const XcdBarrier& b) {
  asm volatile("s_waitcnt vmcnt(0)" ::: "memory");
  __syncthreads();
  if (threadIdx.x == 0) {
    unsigned* bar = b.bar;
    __builtin_amdgcn_s_waitcnt(0);
    unsigned nloc = b.st[0], nx = b.st[1];
    if (nloc == 0u) { xcd_barrier_complete(bar, b.x, nloc, nx); b.st[0] = nloc; b.st[1] = nx; }
    const unsigned old = xb_add(&bar[XB_XSUB(b.x)], 1u);
    const unsigned gen = old / nloc;
    if (old + 1u == (gen + 1u) * nloc) {
      __builtin_amdgcn_fence(__ATOMIC_RELEASE, "agent");
      asm volatile("s_waitcnt vmcnt(0)" ::: "memory");
      const unsigned og = xb_add(&bar[XB_TOP], 1u);
      const unsigned tg = og / nx;
      if (og + 1u == (tg + 1u) * nx) xb_add(&bar[XB_TOPGEN], 1u);
      else XB_SPIN(xb_ld(&bar[XB_TOPGEN]) == tg, bar);
      __builtin_amdgcn_fence(__ATOMIC_ACQUIRE, "agent");
      xb_add(&bar[XB_XGEN(b.x)], 1u);
      asm volatile("s_waitcnt vmcnt(0)" ::: "memory");
    } else {
      XB_SPIN(xb_ld(&bar[XB_XGEN(b.x)]) == gen, bar);
      __builtin_amdgcn_fence(__ATOMIC_ACQUIRE, "agent");
      asm volatile("s_waitcnt vmcnt(0)" ::: "memory");
    }
  }
  __syncthreads();
}

constexpr int LDS_LD = 72;
constexpr int STG = 128 * LDS_LD;

struct G2Regs { u32x4 r0a[4], r0b[4], r1a[4], r1b[4]; };
struct G2Ptrs { const u16* ap; const u16* bp; size_t a32, b32, bextra; };
DI G2Ptrs g2_ptrs(const u16* A, int lda, const u16* Bt, int ldb, size_t bextra) {
  const int tid = tidx();
  const int lr = tid >> 3, lc = (tid & 7) * 8;
  G2Ptrs P; P.ap = A + (size_t)lr * lda + lc; P.bp = Bt + (size_t)lr * ldb + lc; P.a32 = (size_t)32 * lda; P.b32 = (size_t)32 * ldb; P.bextra = bextra;
  return P;
}
#define G2_ISSUE(RA, RB, kt_) do { const u16* a_ = P.ap + (size_t)(kt_) * 64; const u16* b_ = P.bp + (size_t)(kt_) * 64; \
    _Pragma("unroll") for (int i = 0; i < 4; ++i) RA[i] = *(const u32x4*)(a_ + i * P.a32); \
    _Pragma("unroll") for (int i = 0; i < 4; ++i) RB[i] = *(const u32x4*)(b_ + i * P.b32 + (i >= 2 ? P.bextra : (size_t)0)); } while (0)
DI void g2_prefetch(G2Regs& R, const G2Ptrs& P) {
  G2_ISSUE(R.r0a, R.r0b, 0);
  G2_ISSUE(R.r1a, R.r1b, 1);
}
DI void g2_main(f32x16 (&acc)[2][2], G2Regs& R, const G2Ptrs& P, int K, char* smem) {
  u16* S = (u16*)smem;
  const int tid = tidx(), lane = tid & 63, wave = tid >> 6, r32 = lane & 31, hi = lane >> 5;
  const int wm = wave >> 1, wn = wave & 1;
  const int lr = tid >> 3, lc = (tid & 7) * 8;
#define G2_STORE(RA, RB, buf_) do { u16* As_ = S + (buf_) * 2 * STG + lr * LDS_LD + lc; u16* Bs_ = As_ + STG; \
    _Pragma("unroll") for (int i = 0; i < 4; ++i) *(u32x4*)(As_ + i * 32 * LDS_LD) = RA[i]; \
    _Pragma("unroll") for (int i = 0; i < 4; ++i) *(u32x4*)(Bs_ + i * 32 * LDS_LD) = RB[i]; } while (0)
  const u16* afr = S + (wm * 64 + r32) * LDS_LD + hi * 8;
  const u16* bfr = S + STG + (wn * 64 + r32) * LDS_LD + hi * 8;
#define G2_FRAG(buf_, ks_, A0, A1, B0, B1) do { const u16* a_ = afr + (buf_) * 2 * STG + (ks_) * 16; const u16* b_ = bfr + (buf_) * 2 * STG + (ks_) * 16; \
    A0 = *(const bf16x8*)(a_); A1 = *(const bf16x8*)(a_ + 32 * LDS_LD); B0 = *(const bf16x8*)(b_); B1 = *(const bf16x8*)(b_ + 32 * LDS_LD); } while (0)
#define G2_MMA(A0, A1, B0, B1) do { acc[0][0] = MFMA(B0, A0, acc[0][0]); acc[0][1] = MFMA(B1, A0, acc[0][1]); \
    acc[1][0] = MFMA(B0, A1, acc[1][0]); acc[1][1] = MFMA(B1, A1, acc[1][1]); } while (0)
#define G2_COMPUTE(buf_) do { bf16x8 a0, a1, b0, b1, c0, c1, d0, d1; __builtin_amdgcn_iglp_opt(0); \
    G2_FRAG(buf_, 0, a0, a1, b0, b1); G2_FRAG(buf_, 1, c0, c1, d0, d1); __builtin_amdgcn_s_setprio(1); G2_MMA(a0, a1, b0, b1); \
    G2_FRAG(buf_, 2, a0, a1, b0, b1); G2_MMA(c0, c1, d0, d1); \
    G2_FRAG(buf_, 3, c0, c1, d0, d1); G2_MMA(a0, a1, b0, b1); G2_MMA(c0, c1, d0, d1); __builtin_amdgcn_s_setprio(0); } while (0)
  const int KT = K >> 6;
  __syncthreads();
  G2_STORE(R.r0a, R.r0b, 0);
  G2_STORE(R.r1a, R.r1b, 1);
  if (KT > 2) G2_ISSUE(R.r0a, R.r0b, 2);
  if (KT > 3) G2_ISSUE(R.r1a, R.r1b, 3);
  __syncthreads();
  for (int kt = 0; kt < KT; kt += 2) {
    G2_COMPUTE(0);
    __syncthreads();
    if (kt + 2 < KT) {
      G2_STORE(R.r0a, R.r0b, 0);
      if (kt + 4 < KT) G2_ISSUE(R.r0a, R.r0b, kt + 4);
    }
    G2_COMPUTE(1);
    __syncthreads();
    if (kt + 3 < KT) {
      G2_STORE(R.r1a, R.r1b, 1);
      if (kt + 5 < KT) G2_ISSUE(R.r1a, R.r1b, kt + 5);
    }
  }
#undef G2_STORE
#undef G2_FRAG
#undef G2_MMA
#undef G2_COMPUTE
}
DI void gemm2(f32x16 (&acc)[2][2], const u16* A, int lda, const u16* Bt, int ldb, int K, char* smem, size_t bextra = 0) {
  G2Regs R; const G2Ptrs P = g2_ptrs(A, lda, Bt, ldb, bextra);
  g2_prefetch(R, P);
  g2_main(acc, R, P, K, smem);
}

DI void gemm2s(f32x16 (&acc)[2][2], const u16* A, int lda, const u16* Bt, int ldb, int K, char* smem) {
  u16* S = (u16*)smem;
  const int tid = tidx(), lane = tid & 63, wave = tid >> 6, r32 = lane & 31, hi = lane >> 5;
  const int wm = wave >> 1, wn = wave & 1;
  const int lr = tid >> 3, lc = (tid & 7) * 8;
  const u16* ap = A + (size_t)lr * lda + lc;
  const u16* bp = Bt + (size_t)lr * ldb + lc;
  const size_t a32 = (size_t)32 * lda, b32 = (size_t)32 * ldb;
  u32x4 ra[4], rb[4];
  const int KT = K >> 6;
  __syncthreads();
#pragma unroll
  for (int i = 0; i < 4; ++i) { ra[i] = *(const u32x4*)(ap + i * a32); rb[i] = *(const u32x4*)(bp + i * b32); }
#pragma unroll 1
  for (int kt = 0; kt < KT; ++kt) {
    const int cur = kt & 1;
    {
      u16* As_ = S + cur * 2 * STG + lr * LDS_LD + lc; u16* Bs_ = As_ + STG;
#pragma unroll
      for (int i = 0; i < 4; ++i) { *(u32x4*)(As_ + i * 32 * LDS_LD) = ra[i]; *(u32x4*)(Bs_ + i * 32 * LDS_LD) = rb[i]; }
    }
    __syncthreads();
    if (kt + 1 < KT) {
      const u16* a_ = ap + (size_t)(kt + 1) * 64; const u16* b_ = bp + (size_t)(kt + 1) * 64;
#pragma unroll
      for (int i = 0; i < 4; ++i) { ra[i] = *(const u32x4*)(a_ + i * a32); rb[i] = *(const u32x4*)(b_ + i * b32); }
    }
    const u16* As_ = S + cur * 2 * STG; const u16* Bs_ = As_ + STG;
#pragma unroll
    for (int ks = 0; ks < 4; ++ks) {
      const bf16x8 a0 = *(const bf16x8*)(As_ + (wm * 64 + r32) * LDS_LD + ks * 16 + hi * 8);
      const bf16x8 a1 = *(const bf16x8*)(As_ + (wm * 64 + 32 + r32) * LDS_LD + ks * 16 + hi * 8);
      const bf16x8 b0 = *(const bf16x8*)(Bs_ + (wn * 64 + r32) * LDS_LD + ks * 16 + hi * 8);
      const bf16x8 b1 = *(const bf16x8*)(Bs_ + (wn * 64 + 32 + r32) * LDS_LD + ks * 16 + hi * 8);
      acc[0][0] = MFMA(b0, a0, acc[0][0]); acc[0][1] = MFMA(b1, a0, acc[0][1]);
      acc[1][0] = MFMA(b0, a1, acc[1][0]); acc[1][1] = MFMA(b1, a1, acc[1][1]);
    }
  }
  __syncthreads();
}

DI void zero_acc(f32x16 (&acc)[2][2]) {
#pragma unroll
  for (int i = 0; i < 2; ++i)
#pragma unroll
    for (int j = 0; j < 2; ++j)
#pragma unroll
      for (int r = 0; r < 16; ++r) acc[i][j][r] = 0.f;
}

DI void epi_residual(f32x16 (&acc)[2][2], float* x, const float* xin  , const float* gvec, int m0, int n0) {
  const int tid = tidx(), lane = tid & 63, wave = tid >> 6, r32 = lane & 31, hi = lane >> 5;
  const int wm = wave >> 1, wn = wave & 1;
#pragma unroll
  for (int i = 0; i < 2; ++i)
#pragma unroll
    for (int j = 0; j < 2; ++j) {
      const int col = n0 + wn * 64 + j * 32 + 4 * hi;
      float* px = x + (size_t)(m0 + wm * 64 + i * 32 + r32) * DM + col;
      const float* pin = xin + (size_t)(wm * 64 + i * 32 + r32) * DM + col;
#pragma unroll
      for (int g = 0; g < 4; ++g) {
        const f32x4 gv = *(const f32x4*)(gvec + col + 8 * g);
        f32x4 xv = *(const f32x4*)(pin + 8 * g);
#pragma unroll
        for (int e = 0; e < 4; ++e) xv[e] += gv[e] * acc[i][j][4 * g + e];
        *(f32x4*)(px + 8 * g) = xv;
      }
    }
}

DI void phase_norm(const Params& p, int l, int which) {
  const int tid = tidx(), lane = tid & 63, wave = tid >> 6;
  const float* nrm = (which ? p.norm2 : p.norm1) + l * DM;
  const int stride = gridDim.x * 4;
  f32x4 nv[4];
#pragma unroll
  for (int i = 0; i < 4; ++i) nv[i] = *(const f32x4*)(nrm + i * 256 + lane * 4);
  for (int row = blockIdx.x * 4 + wave; row < NTOK; row += stride) {
    const float* mod = p.mod + ((size_t)l * 3 + (row < NCTX ? 0 : 1 + ((row - NCTX) >> 11))) * 6144;
    const float* sc = mod + (which ? 4096 : 1024);
    const float* sh = mod + (which ? 3072 : 0);
    f32x4 v[4], scv[4], shv[4];
    const float* xr = (l == 0 && which == 0) ? ((row < NCTX) ? (p.x_prompt + (size_t)row * DM) : (p.x_sample + (size_t)(row - NCTX) * DM)) : (p.out + (size_t)row * DM);
#pragma unroll
    for (int i = 0; i < 4; ++i) v[i] = *(const f32x4*)(xr + i * 256 + lane * 4);
#pragma unroll
    for (int i = 0; i < 4; ++i) { scv[i] = *(const f32x4*)(sc + i * 256 + lane * 4); shv[i] = *(const f32x4*)(sh + i * 256 + lane * 4); }
    float ssq = 0.f;
#pragma unroll
    for (int i = 0; i < 4; ++i) ssq += v[i][0] * v[i][0] + v[i][1] * v[i][1] + v[i][2] * v[i][2] + v[i][3] * v[i][3];
    ssq += __shfl_xor(ssq, 1); ssq += __shfl_xor(ssq, 2); ssq += __shfl_xor(ssq, 4); ssq += __shfl_xor(ssq, 8);
    ssq += __shfl_xor(ssq, 16); ssq += __shfl_xor(ssq, 32);
    const float r = rsqrtf(ssq * (1.f / 1024.f) + EPS);
#pragma unroll
    for (int i = 0; i < 4; ++i) {
      f32x4 o;
#pragma unroll
      for (int e = 0; e < 4; ++e) o[e] = v[i][e] * r * (nv[i][e] * (1.f + scv[i][e])) + shv[i][e];
      u32x2 w = {pk2(o[0], o[1]), pk2(o[2], o[3])};
      *(u32x2*)(p.h + (size_t)row * DM + i * 256 + lane * 4) = w;
    }
  }
}

DI int cond_of_row(int row) { return row < NCTX ? 0 : 1 + ((row - NCTX) >> 11); }

DI float red16(float v) { v += __shfl_xor(v, 1); v += __shfl_xor(v, 2); v += __shfl_xor(v, 4); v += __shfl_xor(v, 8); return v; }
DI float red32(float v) { v = red16(v); v += __shfl_xor(v, 16); return v; }
DI void st_bf4(u16* dst, f32x4 v) { u32x2 o = {pk2(v[0], v[1]), pk2(v[2], v[3])}; *(u32x2*)dst = o; }

DI f32x4 rope64(f32x4 v, int j16, int prow, int pcol, const float* tabs) {
  const int sec = j16 >> 3; const int pos = sec ? pcol : prow;
  const int fi = (j16 & 3) * 4;
  const f32x4 cs = *(const f32x4*)(tabs + pos * 16 + fi);
  const f32x4 sn = *(const f32x4*)(tabs + 1024 + pos * 16 + fi);
  f32x4 pv; pv[0] = __shfl_xor(v[0], 4); pv[1] = __shfl_xor(v[1], 4); pv[2] = __shfl_xor(v[2], 4); pv[3] = __shfl_xor(v[3], 4);
  const float sgn = ((j16 & 7) < 4) ? -1.f : 1.f;
  f32x4 o;
#pragma unroll
  for (int i = 0; i < 4; ++i) o[i] = v[i] * cs[i] + sgn * pv[i] * sn[i];
  return o;
}
DI f32x4 rope32(f32x4 v, int jj, int prow, int pcol, const float* tabs) {
  const int sec = jj >> 2; const int pos = sec ? pcol : prow;
  const int fi = (jj & 1) * 4;
  const f32x4 cs = *(const f32x4*)(tabs + 2048 + pos * 8 + fi);
  const f32x4 sn = *(const f32x4*)(tabs + 2560 + pos * 8 + fi);
  f32x4 pv; pv[0] = __shfl_xor(v[0], 2); pv[1] = __shfl_xor(v[1], 2); pv[2] = __shfl_xor(v[2], 2); pv[3] = __shfl_xor(v[3], 2);
  const float sgn = ((jj & 3) < 2) ? -1.f : 1.f;
  f32x4 o;
#pragma unroll
  for (int i = 0; i < 4; ++i) o[i] = v[i] * cs[i] + sgn * pv[i] * sn[i];
  return o;
}

DI void mla_tile(const u16* Aptr, const u16* Wtl  , int hd, const float* kpe_src, int kpe_ld, const float* knd,
                 bool lat, int s0  , const float* tabs,
                 u16* kout  , u16* vout  , char* smem, G2Regs& R) {
  f32x16 acc[2][2]; zero_acc(acc);
  { const G2Ptrs Pm = g2_ptrs(Aptr, 128, Wtl + (size_t)hd * 128 * 128, 128, 0); g2_prefetch(R, Pm); g2_main(acc, R, Pm, 128, smem); }
  float* Cs = (float*)smem;
  const int tid = tidx(), lane = tid & 63, wave = tid >> 6, r32 = lane & 31, hi = lane >> 5, wm = wave >> 1, wn = wave & 1;
  const int j16 = tid & 15;
  for (int half = 0; half < 2; ++half) {
    __syncthreads();
    if (wm == half) {
#pragma unroll
      for (int i = 0; i < 2; ++i)
#pragma unroll
        for (int j = 0; j < 2; ++j)
#pragma unroll
          for (int r = 0; r < 16; ++r) Cs[(i * 32 + r32) * 132 + wn * 64 + j * 32 + crow(r, hi)] = acc[i][j][r];
    }
    __syncthreads();
#pragma unroll
    for (int it = 0; it < 4; ++it) {
      const int rl = it * 16 + (tid >> 4);
      const int rowt = half * 64 + rl;
      f32x4 kn = *(const f32x4*)(Cs + rl * 132 + j16 * 4);
      f32x4 kp = {0.f, 0.f, 0.f, 0.f};
      if (j16 < 8) kp = *(const f32x4*)(kpe_src + (size_t)rowt * kpe_ld + j16 * 4);
      float ssq = kn[0] * kn[0] + kn[1] * kn[1] + kn[2] * kn[2] + kn[3] * kn[3] + kp[0] * kp[0] + kp[1] * kp[1] + kp[2] * kp[2] + kp[3] * kp[3];
      ssq = red16(ssq);
      const float r = rsqrtf(ssq * (1.f / 96.f) + EPS);
      const f32x4 g0 = *(const f32x4*)(knd + j16 * 4);
      f32x4 g1 = {0.f, 0.f, 0.f, 0.f};
      if (j16 < 8) g1 = *(const f32x4*)(knd + 64 + j16 * 4);
#pragma unroll
      for (int i = 0; i < 4; ++i) { kn[i] = kn[i] * r * g0[i]; kp[i] = kp[i] * r * g1[i]; }
      if (lat) {
        const int s = s0 + rowt;
        kp = rope32(kp, j16 & 7, s >> 6, s & 63, tabs);
      }
      st_bf4(kout + (size_t)rowt * 96 + j16 * 4, kn);
      if (j16 < 8) st_bf4(kout + (size_t)rowt * 96 + 64 + j16 * 4, kp);
      const f32x4 vv = *(const f32x4*)(Cs + rl * 132 + 64 + j16 * 4);
      st_bf4(vout + (size_t)rowt * 64 + j16 * 4, vv);
    }
  }
}

#define CTRL_MLACNT(l, mt) (3776 + 64 * (l) + (mt))

DI int virt_col(int n) {
  if (n < 1792) return n;
  if (n < 2176) { const int h = (n - 1792) / 96, e = (n - 1792) % 96; return 1792 + h * 128 + e; }
  if (n < 2304) return 2304 + (n - 2176);
  if (n < 2336) return 2432 + (n - 2304);
  return 2560 + (n - 2336);
}

DI void phase_g1(const Params& p, int l, char* smem) {
  const int NT = 64 * 52;
  const u16* W = p.Wt_in + (size_t)l * INP * DM;
  float* Cs = (float*)smem;
  const float *qn_a = p.qn_a, *qn_b = p.qn_b, *qn_c = p.qn_c, *kn_b = p.kn_b, *kn_c = p.kn_c;
  asm volatile("" : "+s"(qn_a), "+s"(qn_b), "+s"(qn_c), "+s"(kn_b), "+s"(kn_c));
  u16* const qkv = p.QA;
  constexpr size_t E4 = (size_t)4 * NTOK * 64, E2 = (size_t)2 * NTOK * 64;
  G2Regs R; G2Ptrs P;
  if ((int)blockIdx.x < NT) { const int t0 = blockIdx.x; P = g2_ptrs(p.h + (size_t)(t0 & 63) * 128 * DM, DM, W + (size_t)(t0 >> 6) * 128 * DM, DM, 0); g2_prefetch(R, P); }
  for (int t = blockIdx.x; t < NT + 272; t += gridDim.x) {
    if (t >= NT) {
      const int it = t - NT;
      const u16* Wtl = p.Wt_ukv + (size_t)l * 512 * 128;
      if (it < 256) {
        const int mt = it & 63, hd = it >> 6;
        const int m0 = mt * 128;
        if (threadIdx.x == 0) {
          unsigned* c = p.ctrl + CTRL_MLACNT(l, mt);
          XB_SPIN(xb_ld(c) < 2u, p.ctrl);
          __builtin_amdgcn_fence(__ATOMIC_ACQUIRE, "agent");
          asm volatile("s_waitcnt vmcnt(0)" ::: "memory");
        }
        __syncthreads();
        const bool lat = m0 >= NCTX;
        const int s0 = lat ? ((m0 - NCTX) & 2047) : (m0 & 255);
        mla_tile(p.ckvn + (size_t)m0 * 128, Wtl, hd, p.kpe + (size_t)m0 * 32, 32,
                 p.kn_d + l * 96, lat, s0, p.tabs, p.KD + ((size_t)hd * NTOK + m0) * 96, p.VD + ((size_t)hd * NTOK + m0) * 64, smem, R);
      } else {
        const int tt = it - 256;
        const int hd = tt & 3, mt2 = (tt >> 2) & 1, b = (tt >> 3) & 1;
        const size_t rbase = ((size_t)(b * 4 + l) * 256 + mt2 * 128);
        const size_t obase = ((size_t)(l * 2 + b) * 4 + hd) * 256 + mt2 * 128;
        mla_tile(p.cckv + rbase * 128, Wtl, hd, p.c_mla_kpe + rbase * 32, 32,
                 p.kn_d + l * 96, false, 0, p.tabs, p.CKD + obase * 96, p.CVD + obase * 64, smem, R);
      }
      continue;
    }
    const int mt = t & 63, nt = t >> 6;
    const int m0 = mt * 128, n0 = nt * 128;
    f32x16 acc[2][2]; zero_acc(acc);
    g2_main(acc, R, P, DM, smem);
    {
      const int tn = t + gridDim.x;
      if (tn < NT) { P = g2_ptrs(p.h + (size_t)(tn & 63) * 128 * DM, DM, W + (size_t)(tn >> 6) * 128 * DM, DM, 0); g2_prefetch(R, P); }
    }
    const int tid = tidx(), lane = tid & 63, wave = tid >> 6, r32 = lane & 31, hi = lane >> 5, wm = wave >> 1, wn = wave & 1;
    if (nt >= 20) {
#pragma unroll
      for (int i = 0; i < 2; ++i)
#pragma unroll
        for (int j = 0; j < 2; ++j) {
          u16* q = p.gates + (size_t)(m0 + wm * 64 + i * 32 + r32) * 4096 + (n0 - 2560) + wn * 64 + j * 32 + 4 * hi;
#pragma unroll
          for (int g = 0; g < 4; ++g) {
            u32x2 w = {pk2(sigmoidf_(acc[i][j][4 * g]), sigmoidf_(acc[i][j][4 * g + 1])), pk2(sigmoidf_(acc[i][j][4 * g + 2]), sigmoidf_(acc[i][j][4 * g + 3]))};
            *(u32x2*)(q + 8 * g) = w;
          }
        }
      continue;
    }
#pragma unroll
    for (int i = 0; i < 2; ++i)
#pragma unroll
      for (int j = 0; j < 2; ++j)
#pragma unroll
        for (int g = 0; g < 4; ++g) {
          f32x4 v = {acc[i][j][4 * g], acc[i][j][4 * g + 1], acc[i][j][4 * g + 2], acc[i][j][4 * g + 3]};
          *(f32x4*)(Cs + (wm * 64 + i * 32 + r32) * 132 + wn * 64 + j * 32 + 8 * g + 4 * hi) = v;
        }
    __syncthreads();
    const bool lat = m0 >= NCTX;
    const int bb = lat ? ((m0 - NCTX) >> 11) : (m0 >> 8);
    const int sbase = lat ? ((m0 - NCTX) & 2047) : (m0 & 255);
    if (nt < 14) {
      const int c = nt >> 1, half = nt & 1;
      const int j16 = tid & 15, hsel = (tid >> 4) & 1, hh = half * 2 + hsel;
      f32x4 gn = {1.f, 1.f, 1.f, 1.f};
      if (c == 0 || c == 3 || c == 5) gn = *(const f32x4*)((c == 0 ? qn_a : c == 3 ? qn_b : qn_c) + l * 64 + j16 * 4);
      else if (c == 1) gn = *(const f32x4*)(p.kn_a + l * 64 + j16 * 4);
      else if (c != 2 && half == 0) gn = *(const f32x4*)((c == 4 ? kn_b : kn_c) + l * 64 + j16 * 4);
      for (int ps = 0; ps < 16; ++ps) {
        const int rowl = ps * 8 + (tid >> 5);
        const int tok = m0 + rowl, s = sbase + rowl;
        const int prow = s >> 6, pcol = s & 63;
        const size_t cbase = ((size_t)(bb * 4 + l) * 256 + s);
        f32x4 v = *(const f32x4*)(Cs + rowl * 132 + hsel * 64 + j16 * 4);
        const float ssq = red16(v[0] * v[0] + v[1] * v[1] + v[2] * v[2] + v[3] * v[3]);
        const float r = rsqrtf(ssq * (1.f / 64.f) + EPS);
        if (c == 0 || c == 3 || c == 5) {
#pragma unroll
          for (int e = 0; e < 4; ++e) v[e] = v[e] * r * gn[e];
          if (lat && c != 0) v = rope64(v, j16, prow, pcol, p.tabs);
#pragma unroll
          for (int e = 0; e < 4; ++e) v[e] *= QS64;
          st_bf4(qkv + (size_t)c * E4 + ((size_t)hh * NTOK + tok) * 64 + j16 * 4, v);
        } else if (c == 1) {
#pragma unroll
          for (int e = 0; e < 4; ++e) v[e] = v[e] * r * gn[e];
          if (!lat) *(f32x4*)(p.out + O_NATK + cbase * 256 + hh * 64 + j16 * 4) = v;
          st_bf4(p.KA + ((size_t)hh * NTOK + tok) * 64 + j16 * 4, v);
        } else if (c == 2) {
          if (!lat) *(f32x4*)(p.out + O_NATV + cbase * 256 + hh * 64 + j16 * 4) = v;
          st_bf4(p.VA + ((size_t)hh * NTOK + tok) * 64 + j16 * 4, v);
        } else if (half == 0) {
#pragma unroll
          for (int e = 0; e < 4; ++e) v[e] = v[e] * r * gn[e];
          if (!lat) *(f32x4*)(p.out + (c == 4 ? O_GQAK : O_WINK) + cbase * 128 + hsel * 64 + j16 * 4) = v;
          if (lat) v = rope64(v, j16, prow, pcol, p.tabs);
          st_bf4(qkv + (size_t)c * E4 + ((size_t)hsel * NTOK + tok) * 64 + j16 * 4, v);
        } else {
          if (!lat) *(f32x4*)(p.out + (c == 4 ? O_GQAV : O_WINV) + cbase * 128 + hsel * 64 + j16 * 4) = v;
          st_bf4(qkv + (size_t)c * E4 + E2 + ((size_t)hsel * NTOK + tok) * 64 + j16 * 4, v);
        }
      }
    } else if (nt < 18) {
      const int head = nt - 14, l32 = tid & 31;
      const bool actv = l32 < 24;
      f32x4 g = {0.f, 0.f, 0.f, 0.f};
      if (actv) g = *(const f32x4*)(p.qn_d + l * 96 + l32 * 4);
      for (int ps = 0; ps < 16; ++ps) {
        const int rowl = ps * 8 + (tid >> 5);
        const int tok = m0 + rowl, s = sbase + rowl;
        f32x4 v = {0.f, 0.f, 0.f, 0.f};
        if (actv) v = *(const f32x4*)(Cs + rowl * 132 + l32 * 4);
        const float ssq = red32(v[0] * v[0] + v[1] * v[1] + v[2] * v[2] + v[3] * v[3]);
        const float r = rsqrtf(ssq * (1.f / 96.f) + EPS);
#pragma unroll
        for (int e = 0; e < 4; ++e) v[e] = v[e] * r * g[e];
        if (lat) {
          const f32x4 rv = rope32(v, (l32 - 16) & 7, s >> 6, s & 63, p.tabs);
          if (l32 >= 16 && l32 < 24) v = rv;
        }
#pragma unroll
        for (int e = 0; e < 4; ++e) v[e] *= QS96;
        if (actv) st_bf4(p.QD + ((size_t)head * NTOK + tok) * 96 + l32 * 4, v);
      }
    } else if (nt == 18) {
      const int l32 = tid & 31;
      const f32x4 g = *(const f32x4*)(p.kvn_d + l * 128 + l32 * 4);
      for (int ps = 0; ps < 16; ++ps) {
        const int rowl = ps * 8 + (tid >> 5);
        const int tok = m0 + rowl, s = sbase + rowl;
        f32x4 v = *(const f32x4*)(Cs + rowl * 132 + l32 * 4);
        const float ssq = red32(v[0] * v[0] + v[1] * v[1] + v[2] * v[2] + v[3] * v[3]);
        const float r = rsqrtf(ssq * (1.f / 128.f) + EPS);
#pragma unroll
        for (int e = 0; e < 4; ++e) v[e] = v[e] * r * g[e];
        if (!lat) *(f32x4*)(p.out + O_CKV + ((size_t)(bb * 4 + l) * 256 + s) * 128 + l32 * 4) = v;
        st_bf4(p.ckvn + (size_t)tok * 128 + l32 * 4, v);
      }
    } else {
      const int j8 = tid & 7;
      for (int ps = 0; ps < 4; ++ps) {
        const int rowl = ps * 32 + (tid >> 3);
        const int tok = m0 + rowl, s = sbase + rowl;
        const f32x4 v = *(const f32x4*)(Cs + rowl * 132 + j8 * 4);
        if (!lat) *(f32x4*)(p.out + O_KPE + ((size_t)(bb * 4 + l) * 256 + s) * 32 + j8 * 4) = v;
        *(f32x4*)(p.kpe + (size_t)tok * 32 + j8 * 4) = v;
      }
    }
    if (nt == 18 || nt == 19) {
      asm volatile("s_waitcnt vmcnt(0)" ::: "memory");
      __syncthreads();
      if (threadIdx.x == 0) {
        __builtin_amdgcn_fence(__ATOMIC_RELEASE, "agent");
        asm volatile("s_waitcnt vmcnt(0)" ::: "memory");
        xb_add(p.ctrl + CTRL_MLACNT(l, mt), 1u);
      }
    }
  }
}

DI s16x4 vtr(const u16* pp) { return __builtin_bit_cast(s16x4, __builtin_amdgcn_ds_read_tr16_b64_v4i16((LAS v4i16_t*)(pp))); }

template <int DQ>
DI void attn_run(const u16* qptr, int nt0, const u16* k0p, const u16* v0p, int nt1, const u16* k1p, const u16* v1p,
                 int mode, int kpos1, int qpos0, bool has_sink, float sink2, const float* rpb_g, u16* outp, char* smem) {
  constexpr int DQ16 = DQ / 16, KS = DQ + 8, NKR = DQ / 32, CPR = DQ / 8;
  constexpr int BUFE = 64 * KS + 64 * 72;
  u16* Ks0 = (u16*)smem; float* rpb_s = (float*)(Ks0 + 2 * BUFE);
  const int tid = tidx(), lane = tid & 63, wave = tid >> 6, r32 = lane & 31, hi = lane >> 5;
  __syncthreads();
  if (mode == 2) { for (int i = tid; i < 465; i += 256) rpb_s[i] = rpb_g[i] * LOG2E; }
  bf16x8 qf[DQ16];
  {
    const u16* qrow = qptr + (size_t)(wave * 32 + r32) * DQ + hi * 8;
#pragma unroll
    for (int d0 = 0; d0 < DQ16; ++d0) qf[d0] = *(const bf16x8*)(qrow + d0 * 16);
  }
  f32x16 o0, o1;
#pragma unroll
  for (int r = 0; r < 16; ++r) { o0[r] = 0.f; o1[r] = 0.f; }
  float m = 0.f, lsum = 0.f;
  f32x16 negm;
#pragma unroll
  for (int r = 0; r < 16; ++r) negm[r] = 0.f;
  const int ntot = nt0 + nt1;
  u32x4 kr[NKR], vr[2];
  auto issue = [&](int t) {
    const u16* kp = (t < nt0) ? (k0p + (size_t)t * 64 * DQ) : (k1p + (size_t)(t - nt0) * 64 * DQ);
    const u16* vp = (t < nt0) ? (v0p + (size_t)t * 64 * 64) : (v1p + (size_t)(t - nt0) * 64 * 64);
#pragma unroll
    for (int i = 0; i < NKR; ++i) kr[i] = *(const u32x4*)(kp + (size_t)(i * 256 + tid) * 8);
#pragma unroll
    for (int i = 0; i < 2; ++i) vr[i] = *(const u32x4*)(vp + (size_t)(i * 256 + tid) * 8);
  };
  auto stage = [&](int buf) {
    u16* Ks = Ks0 + buf * BUFE; u16* Vs = Ks + 64 * KS;
#pragma unroll
    for (int i = 0; i < NKR; ++i) { const int c = i * 256 + tid; const int row = c / CPR, col = c % CPR; *(u32x4*)(Ks + row * KS + col * 8) = kr[i]; }
#pragma unroll
    for (int i = 0; i < 2; ++i) { const int c = i * 256 + tid; const int row = c >> 3, col = c & 7; *(u32x4*)(Vs + row * 72 + col * 8) = vr[i]; }
  };
  issue(0);
  stage(0);
  if (ntot > 1) issue(1);
  __syncthreads();
  const int qpos = qpos0 + wave * 32 + r32;
  const int qr = qpos >> 6, qc = qpos & 63;
  int r0q = qr - 4; r0q = r0q < 0 ? 0 : (r0q > 24 ? 24 : r0q);
  int c0q = qc - 8; c0q = c0q < 0 ? 0 : (c0q > 48 ? 48 : c0q);
  const int vofs = 64 * KS + (4 * hi + ((lane & 15) >> 2)) * 72 + ((lane >> 4) & 1) * 16 + (lane & 3) * 4;
  for (int t = 0; t < ntot; ++t) {
    const u16* Ks = Ks0 + (t & 1) * BUFE;
    const u16* vbase = Ks + vofs;
    f32x16 p0 = negm, p1 = negm;
    __builtin_amdgcn_iglp_opt(0);
#pragma unroll
    for (int d0 = 0; d0 < DQ16; ++d0) {
      const bf16x8 ka = *(const bf16x8*)(Ks + r32 * KS + d0 * 16 + hi * 8);
      const bf16x8 kb = *(const bf16x8*)(Ks + (32 + r32) * KS + d0 * 16 + hi * 8);
      p0 = MFMA(ka, qf[d0], p0); p1 = MFMA(kb, qf[d0], p1);
    }
    if (t >= nt0 && mode != 0) {
      const int kt = t - nt0;
      if (mode == 1) {
        const int kb0 = kpos1 + kt * 64;
#pragma unroll
        for (int r = 0; r < 16; ++r) {
          const int kp = kb0 + crow(r, hi);
          int d = qpos - kp; d = d < 0 ? -d : d;
          if (d > 128) p0[r] = -1e30f;
          int d2 = qpos - (kp + 32); d2 = d2 < 0 ? -d2 : d2;
          if (d2 > 128) p1[r] = -1e30f;
        }
      } else {
        const int krow_ = kpos1 + kt;
        const bool rowok = (krow_ >= r0q) && (krow_ < r0q + 8);
        const int dr = krow_ - qr + 7;
#pragma unroll
        for (int r = 0; r < 16; ++r) {
          {
            const int kc = crow(r, hi);
            const bool ok = rowok && (kc >= c0q) && (kc < c0q + 16);
            int dc = kc - qc; dc = dc < -15 ? -15 : (dc > 15 ? 15 : dc);
            const int idx = ok ? (dr * 31 + dc + 15) : 0;
            const float bv = rpb_s[idx];
            p0[r] = ok ? p0[r] + bv : -1e30f;
          }
          {
            const int kc = 32 + crow(r, hi);
            const bool ok = rowok && (kc >= c0q) && (kc < c0q + 16);
            int dc = kc - qc; dc = dc < -15 ? -15 : (dc > 15 ? 15 : dc);
            const int idx = ok ? (dr * 31 + dc + 15) : 0;
            const float bv = rpb_s[idx];
            p1[r] = ok ? p1[r] + bv : -1e30f;
          }
        }
      }
    }
    float mxa = fmaxf(fmaxf(p0[0], p0[1]), p1[0]), mxb = fmaxf(fmaxf(p0[2], p0[3]), p1[1]);
    mxa = fmaxf(fmaxf(mxa, p1[2]), p1[3]);
#pragma unroll
    for (int r = 4; r < 16; r += 4) {
      mxa = fmaxf(fmaxf(mxa, p0[r]), p0[r + 1]); mxb = fmaxf(fmaxf(mxb, p0[r + 2]), p0[r + 3]);
      mxa = fmaxf(fmaxf(mxa, p1[r]), p1[r + 1]); mxb = fmaxf(fmaxf(mxb, p1[r + 2]), p1[r + 3]);
    }
    float mx = fmaxf(mxa, mxb);
    mx = fmaxf(mx, __shfl_xor(mx, 32));
    if (__builtin_amdgcn_ballot_w64(mx > 8.f) != 0ull) {
      const float d = (mx > 8.f) ? mx : 0.f;
      const float alpha = ex2(-d);
      m += d; lsum *= alpha;
#pragma unroll
      for (int r = 0; r < 16; ++r) { o0[r] *= alpha; o1[r] *= alpha; p0[r] -= d; p1[r] -= d; negm[r] = -m; }
    }
    float rs = 0.f;
#pragma unroll
    for (int r = 0; r < 16; ++r) { p0[r] = ex2(p0[r]); p1[r] = ex2(p1[r]); rs += p0[r] + p1[r]; }
    lsum += rs;
    if (t + 1 < ntot) { stage((t + 1) & 1); if (t + 2 < ntot) issue(t + 2); }
#pragma unroll
    for (int s = 0; s < 4; ++s) {
      u32x4 pw;
      if (s < 2) { pw[0] = pk2(p0[8 * s + 0], p0[8 * s + 1]); pw[1] = pk2(p0[8 * s + 2], p0[8 * s + 3]); pw[2] = pk2(p0[8 * s + 4], p0[8 * s + 5]); pw[3] = pk2(p0[8 * s + 6], p0[8 * s + 7]); }
      else { const int ss = s - 2; pw[0] = pk2(p1[8 * ss + 0], p1[8 * ss + 1]); pw[1] = pk2(p1[8 * ss + 2], p1[8 * ss + 3]); pw[2] = pk2(p1[8 * ss + 4], p1[8 * ss + 5]); pw[3] = pk2(p1[8 * ss + 6], p1[8 * ss + 7]); }
      const bf16x8 pf = __builtin_bit_cast(bf16x8, pw);
      const u16* vb = vbase + (16 * s) * 72;
      {
        const s16x4 lo = vtr(vb), hi4 = vtr(vb + 8 * 72);
        const bf16x8 vf = __builtin_shufflevector(lo, hi4, 0, 1, 2, 3, 4, 5, 6, 7);
        o0 = MFMA(vf, pf, o0);
      }
      {
        const s16x4 lo = vtr(vb + 32), hi4 = vtr(vb + 8 * 72 + 32);
        const bf16x8 vf = __builtin_shufflevector(lo, hi4, 0, 1, 2, 3, 4, 5, 6, 7);
        o1 = MFMA(vf, pf, o1);
      }
    }
    __syncthreads();
  }
  float lt = lsum + __shfl_xor(lsum, 32);
  if (has_sink) lt += ex2(sink2 - m);
  const float inv = 1.f / lt;
  u16* orow = outp + (size_t)(wave * 32 + r32) * 1024;
#pragma unroll
  for (int g = 0; g < 4; ++g) {
    u32x2 w0 = {pk2(o0[4 * g] * inv, o0[4 * g + 1] * inv), pk2(o0[4 * g + 2] * inv, o0[4 * g + 3] * inv)};
    *(u32x2*)(orow + 8 * g + 4 * hi) = w0;
    u32x2 w1 = {pk2(o1[4 * g] * inv, o1[4 * g + 1] * inv), pk2(o1[4 * g + 2] * inv, o1[4 * g + 3] * inv)};
    *(u32x2*)(orow + 32 + 8 * g + 4 * hi) = w1;
  }
}

DI void attn_item(const Params& p, int l, int item, char* smem) {
  int mix, lat, b, h, qt;
  if (item < 512) {
    const int g = item >> 7; mix = (g == 0) ? 3 : (g == 1) ? 1 : (g == 2) ? 0 : 2; lat = 1;
    const int i = item & 127; b = i >> 6; h = (i >> 4) & 3; qt = i & 15;
  } else {
    const int g = (item - 512) >> 7; mix = (g == 0) ? 3 : (g - 1); lat = 0;
    const int i = item & 127; b = i >> 3; h = (i >> 1) & 3; qt = i & 1;
  }
  const int tb = lat ? (NCTX + b * 2048) : (b * 256);
  const int q0 = qt * 128;
  const int hkv = (mix == 1 || mix == 2) ? (h >> 1) : h;
  const int HKV = (mix == 1 || mix == 2) ? 2 : 4;
  u16* outp = p.br + (size_t)(tb + q0) * 1024 + mix * 256 + h * 64;
  const bool has_sink = (mix == 2);
  const float sink2 = has_sink ? p.sink_c[l * 4 + h] * LOG2E : 0.f;
  const u16 *Q, *K, *V, *CK, *CV;
  if (mix == 0) { Q = p.QA; K = p.KA; V = p.VA; CK = p.CKA; CV = p.CVA; }
  else if (mix == 1) { Q = p.QB; K = p.KB; V = p.VB; CK = p.CKB; CV = p.CVB; }
  else if (mix == 2) { Q = p.QC; K = p.KC; V = p.VC; CK = p.CKC; CV = p.CVC; }
  else { Q = p.QD; K = p.KD; V = p.VD; CK = p.CKD; CV = p.CVD; }
  const int DQ = (mix == 3) ? 96 : 64;
  const u16* qptr = Q + ((size_t)h * NTOK + tb + q0) * DQ;
  const u16* kown = K + ((size_t)hkv * NTOK + tb) * DQ;
  const u16* vown = V + ((size_t)hkv * NTOK + tb) * 64;
  int nt0, nt1 = 0, mode = 0, kpos1 = 0;
  const u16 *k0p, *v0p, *k1p = kown, *v1p = vown;
  if (!lat) { nt0 = 4; k0p = kown; v0p = vown; }
  else {
    nt0 = 4;
    const size_t cs = ((size_t)(l * 2 + b) * HKV + hkv) * 256;
    k0p = CK + cs * DQ; v0p = CV + cs * 64;
    if (mix == 1 || mix == 3) { nt1 = 32; }
    else if (mix == 2) {
      int lo = q0 - 128; if (lo < 0) lo = 0; int hi_ = q0 + 256; if (hi_ > 2048) hi_ = 2048;
      nt1 = (hi_ - lo) >> 6; kpos1 = lo; mode = 1;
      k1p = kown + (size_t)lo * DQ; v1p = vown + (size_t)lo * 64;
    } else {
      const int R = qt * 2;
      int ra = R - 4; ra = ra < 0 ? 0 : (ra > 24 ? 24 : ra);
      int rb = R + 1 - 4; rb = rb < 0 ? 0 : (rb > 24 ? 24 : rb);
      nt1 = rb + 8 - ra; kpos1 = ra; mode = 2;
      k1p = kown + (size_t)ra * 64 * DQ; v1p = vown + (size_t)ra * 64 * 64;
    }
  }
  const float* rpb_g = p.rpb_a + ((size_t)l * 4 + h) * 465;
  if (mix == 3) attn_run<96>(qptr, nt0, k0p, v0p, nt1, k1p, v1p, mode, kpos1, q0, has_sink, sink2, rpb_g, outp, smem);
  else attn_run<64>(qptr, nt0, k0p, v0p, nt1, k1p, v1p, mode, kpos1, q0, has_sink, sink2, rpb_g, outp, smem);
}

DI void phase_attn(const Params& p, int l, char* smem, LAS unsigned* s_item) {
  unsigned* ctr = p.ctrl + CTRL_QUEUE(l);
  for (;;) {
    __syncthreads();
    if (tidx() == 0) *s_item = atomicAdd(ctr, 1u);
    __syncthreads();
    const int item = (int)*s_item;
    if (item >= 1024) break;
    attn_item(p, l, item, smem);
  }
}

DI void phase_merge(const Params& p, int l, char* smem) {
  const u16* W = p.Wt_br + (size_t)l * DM * DM;
  u16* S = (u16*)smem;
  for (int t = blockIdx.x; t < 512; t += gridDim.x) {
    const int mt = t & 63, nt = t >> 6;
    const int m0 = mt * 128, n0 = nt * 128;
    const int tid = tidx(), lane = tid & 63, wave = tid >> 6, r32 = lane & 31, hi = lane >> 5, wm = wave >> 1, wn = wave & 1;
    const int lr = tid >> 3, lc = (tid & 7) * 8;
    const u16* ap = p.br + (size_t)(m0 + lr) * 1024 + lc;
    const u16* bp = W + (size_t)(n0 + lr) * DM + lc;
    f32x16 tot[2][2], acc[2][2]; zero_acc(tot); zero_acc(acc);
    u32x4 ra[4], rb[4];
    __syncthreads();
#pragma unroll
    for (int i = 0; i < 4; ++i) { ra[i] = *(const u32x4*)(ap + (size_t)i * 32 * 1024); rb[i] = *(const u32x4*)(bp + (size_t)i * 32 * DM); }
#pragma unroll 1
    for (int n = 0; n < 4; ++n) {
#pragma unroll
      for (int kq = 0; kq < 4; ++kq) {
        const int kt = n * 4 + kq, cur = kq & 1;
        {
          u16* As_ = S + cur * 2 * STG + lr * LDS_LD + lc; u16* Bs_ = As_ + STG;
#pragma unroll
          for (int i = 0; i < 4; ++i) { *(u32x4*)(As_ + i * 32 * LDS_LD) = ra[i]; *(u32x4*)(Bs_ + i * 32 * LDS_LD) = rb[i]; }
        }
        __syncthreads();
        {
          const int kn = (kt + 1 < 16) ? kt + 1 : 15;
#pragma unroll
          for (int i = 0; i < 4; ++i) { ra[i] = *(const u32x4*)(ap + (size_t)i * 32 * 1024 + kn * 64); rb[i] = *(const u32x4*)(bp + (size_t)i * 32 * DM + kn * 64); }
        }
        const u16* As_ = S + cur * 2 * STG; const u16* Bs_ = As_ + STG;
        __builtin_amdgcn_iglp_opt(0);
#pragma unroll
        for (int ks = 0; ks < 4; ++ks) {
          const bf16x8 a0 = *(const bf16x8*)(As_ + (wm * 64 + r32) * LDS_LD + ks * 16 + hi * 8);
          const bf16x8 a1 = *(const bf16x8*)(As_ + (wm * 64 + 32 + r32) * LDS_LD + ks * 16 + hi * 8);
          const bf16x8 b0 = *(const bf16x8*)(Bs_ + (wn * 64 + r32) * LDS_LD + ks * 16 + hi * 8);
          const bf16x8 b1 = *(const bf16x8*)(Bs_ + (wn * 64 + 32 + r32) * LDS_LD + ks * 16 + hi * 8);
          acc[0][0] = MFMA(b0, a0, acc[0][0]); acc[0][1] = MFMA(b1, a0, acc[0][1]);
          acc[1][0] = MFMA(b0, a1, acc[1][0]); acc[1][1] = MFMA(b1, a1, acc[1][1]);
        }
      }
      int gofs = (m0 + wm * 64 + r32) * 4096 + n * 1024 + n0 + wn * 64 + 4 * hi;
      asm volatile("" : "+v"(gofs));
      const u16* gb = p.gates;
#pragma unroll
      for (int i = 0; i < 2; ++i)
#pragma unroll
        for (int j = 0; j < 2; ++j) {
          asm volatile("" ::: "memory");
#pragma unroll
          for (int g = 0; g < 4; ++g) {
            const u32x2 gw = *(const u32x2*)(gb + gofs + i * 32 * 4096 + j * 32 + 8 * g);
            tot[i][j][4 * g + 0] += bf_lo(gw[0]) * acc[i][j][4 * g + 0];
            tot[i][j][4 * g + 1] += bf_hi(gw[0]) * acc[i][j][4 * g + 1];
            tot[i][j][4 * g + 2] += bf_lo(gw[1]) * acc[i][j][4 * g + 2];
            tot[i][j][4 * g + 3] += bf_hi(gw[1]) * acc[i][j][4 * g + 3];
            acc[i][j][4 * g + 0] = 0.f; acc[i][j][4 * g + 1] = 0.f; acc[i][j][4 * g + 2] = 0.f; acc[i][j][4 * g + 3] = 0.f;
          }
        }
    }
#pragma unroll
    for (int i = 0; i < 2; ++i)
#pragma unroll
      for (int j = 0; j < 2; ++j) {
        u16* q = p.merged + (size_t)(m0 + wm * 64 + i * 32 + r32) * DM + n0 + wn * 64 + j * 32 + 4 * hi;
#pragma unroll
        for (int g = 0; g < 4; ++g) {
          u32x2 w = {pk2(tot[i][j][4 * g], tot[i][j][4 * g + 1]), pk2(tot[i][j][4 * g + 2], tot[i][j][4 * g + 3])};
          *(u32x2*)(q + 8 * g) = w;
        }
      }
  }
}

DI void phase_outproj(const Params& p, int l, char* smem) {
  const u16* W = p.Wt_out + (size_t)l * DM * DM;
  for (int t = blockIdx.x; t < 512; t += gridDim.x) {
    const int mt = t & 63, nt = t >> 6;
    const int m0 = mt * 128, n0 = nt * 128;
    f32x16 acc[2][2]; zero_acc(acc);
    gemm2(acc, p.merged + (size_t)m0 * DM, DM, W + (size_t)n0 * DM, DM, DM, smem);
    const float* mod = p.mod + ((size_t)l * 3 + cond_of_row(m0)) * 6144;
    const float* xin = (l == 0) ? ((m0 < NCTX) ? (p.x_prompt + (size_t)m0 * DM) : (p.x_sample + (size_t)(m0 - NCTX) * DM)) : (p.out + (size_t)m0 * DM);
    epi_residual(acc, p.out, xin, mod + 2048, m0, n0);
  }
}

struct ConvW { f32x4 wa0, wa1, wa2, wg0, wg1, wg2, ba, bg; };
DI ConvW conv_load(const float* cw, const float* cb, int ca_col) {
  ConvW w;
  w.wa0 = *(const f32x4*)(cw + ca_col); w.wa1 = *(const f32x4*)(cw + UPC + ca_col); w.wa2 = *(const f32x4*)(cw + 2 * UPC + ca_col);
  w.wg0 = *(const f32x4*)(cw + DFF + ca_col); w.wg1 = *(const f32x4*)(cw + UPC + DFF + ca_col); w.wg2 = *(const f32x4*)(cw + 2 * UPC + DFF + ca_col);
  w.ba = *(const f32x4*)(cb + ca_col); w.bg = *(const f32x4*)(cb + DFF + ca_col);
  return w;
}
DI void conv_act4(const f32x4& ua, const f32x4& ca, const f32x4& da, const f32x4& ug, const f32x4& cg, const f32x4& dg, const ConvW& w, u16* dst) {
  float o[4];
#pragma unroll
  for (int e = 0; e < 4; ++e) {
    const float a = w.ba[e] + w.wa0[e] * ua[e] + w.wa1[e] * ca[e] + w.wa2[e] * da[e];
    const float g = w.bg[e] + w.wg0[e] * ug[e] + w.wg1[e] * cg[e] + w.wg2[e] * dg[e];
    o[e] = siluf_(g) * a;
  }
  u32x2 pk = {pk2(o[0], o[1]), pk2(o[2], o[3])};
  *(u32x2*)dst = pk;
}

DI void phase_up(const Params& p, int l, char* smem) {
  const u16* W = p.Wt_up + (size_t)l * UPC * DM;
  const float* cw = p.conv_w + (size_t)l * 3 * UPC;
  const float* cb = p.conv_b + (size_t)l * UPC;
  float* Cs = (float*)smem;
  const int NT = 64 * 44;
  G2Regs R; G2Ptrs P;
  const size_t bex = (size_t)(DFF - 64) * DM;
  if ((int)blockIdx.x < NT) { const int t0 = blockIdx.x; P = g2_ptrs(p.h + (size_t)(t0 & 63) * 128 * DM, DM, W + (size_t)(t0 >> 6) * 64 * DM, DM, bex); g2_prefetch(R, P); }
  for (int t = blockIdx.x; t < NT; t += gridDim.x) {
    const int mt = t & 63, nt = t >> 6;
    const int m0 = mt * 128, n0 = nt * 64;
    f32x16 acc[2][2]; zero_acc(acc);
    g2_main(acc, R, P, DM, smem);
    {
      const int tn = t + gridDim.x;
      if (tn < NT) { P = g2_ptrs(p.h + (size_t)(tn & 63) * 128 * DM, DM, W + (size_t)(tn >> 6) * 64 * DM, DM, bex); g2_prefetch(R, P); }
    }
    const int tid = tidx(), lane = tid & 63, wave = tid >> 6, r32 = lane & 31, hi = lane >> 5, wm = wave >> 1, wn = wave & 1;
#pragma unroll
    for (int i = 0; i < 2; ++i)
#pragma unroll
      for (int j = 0; j < 2; ++j)
#pragma unroll
        for (int g = 0; g < 4; ++g) {
          f32x4 v = {acc[i][j][4 * g], acc[i][j][4 * g + 1], acc[i][j][4 * g + 2], acc[i][j][4 * g + 3]};
          *(f32x4*)(Cs + (wm * 64 + i * 32 + r32) * 132 + wn * 64 + j * 32 + 8 * g + 4 * hi) = v;
        }
    __syncthreads();
    const int T = (m0 < NCTX) ? 256 : 2048;
    const int s0 = (m0 < NCTX) ? (m0 & 255) : ((m0 - NCTX) & 2047);
    const bool first = (s0 == 0), last = (s0 + 128 == T);
    const int c4 = (tid & 15) * 4;
    const f32x4 z4 = {0.f, 0.f, 0.f, 0.f};
    const ConvW cwt = conv_load(cw, cb, n0 + c4);
#pragma unroll 2
    for (int k = 0; k < 8; ++k) {
      const int row = (tid >> 4) + 16 * k;
      if ((row == 0 && !first) || (row == 127 && !last)) continue;
      const float* cr = Cs + row * 132 + c4;
      const f32x4 ca = *(const f32x4*)cr, cg = *(const f32x4*)(cr + 64);
      f32x4 ua = z4, ug = z4, da = z4, dg = z4;
      if (row > 0) { ua = *(const f32x4*)(cr - 132); ug = *(const f32x4*)(cr - 132 + 64); }
      if (row < 127) { da = *(const f32x4*)(cr + 132); dg = *(const f32x4*)(cr + 132 + 64); }
      conv_act4(ua, ca, da, ug, cg, dg, cwt, p.act + (size_t)(m0 + row) * DFF + n0 + c4);
    }
    if (tid < 128) {
      const int gc = (tid < 64) ? (n0 + tid) : (DFF + n0 + tid - 64);
      float* ubp = p.ub + (size_t)mt * 4 * UPC + gc;
      ubp[0] = Cs[0 * 132 + tid]; ubp[UPC] = Cs[1 * 132 + tid]; ubp[2 * UPC] = Cs[126 * 132 + tid]; ubp[3 * UPC] = Cs[127 * 132 + tid];
    }
  }
}

DI void phase_down(const Params& p, int l, char* smem) {
  const u16* W = p.Wt_down + (size_t)l * DM * DFF;
  const float* cw = p.conv_w + (size_t)l * 3 * UPC;
  const float* cb = p.conv_b + (size_t)l * UPC;
  for (int t = blockIdx.x; t < 512; t += gridDim.x) {
    const int mt = t & 63, nt = t >> 6;
    const int m0 = mt * 128, n0 = nt * 128;
    {
      const int tid = tidx();
      const int T = (m0 < NCTX) ? 256 : 2048;
      const int s0 = (m0 < NCTX) ? (m0 & 255) : ((m0 - NCTX) & 2047);
      const bool first = (s0 == 0), last = (s0 + 128 == T);
      for (int idx = tid; idx < 2 * 704; idx += 256) {
        const int rsel = idx / 704, c4 = (idx % 704) * 4;
        if ((rsel == 0 && first) || (rsel == 1 && last)) continue;
        const float* u_up = rsel ? (p.ub + ((size_t)mt * 4 + 2) * UPC) : (p.ub + ((size_t)(mt - 1) * 4 + 3) * UPC);
        const float* u_cu = rsel ? (p.ub + ((size_t)mt * 4 + 3) * UPC) : (p.ub + ((size_t)mt * 4 + 0) * UPC);
        const float* u_dn = rsel ? (p.ub + ((size_t)(mt + 1) * 4 + 0) * UPC) : (p.ub + ((size_t)mt * 4 + 1) * UPC);
        const f32x4 ua = *(const f32x4*)(u_up + c4), ca = *(const f32x4*)(u_cu + c4), da = *(const f32x4*)(u_dn + c4);
        const f32x4 ug = *(const f32x4*)(u_up + DFF + c4), cg = *(const f32x4*)(u_cu + DFF + c4), dg = *(const f32x4*)(u_dn + DFF + c4);
        const ConvW cwt = conv_load(cw, cb, c4);
        conv_act4(ua, ca, da, ug, cg, dg, cwt, p.act + (size_t)(m0 + (rsel ? 127 : 0)) * DFF + c4);
      }
      asm volatile("s_waitcnt vmcnt(0)" ::: "memory");
    }
    f32x16 acc[2][2]; zero_acc(acc);
    gemm2(acc, p.act + (size_t)m0 * DFF, DFF, W + (size_t)n0 * DFF, DFF, DFF, smem);
    const float* mod = p.mod + ((size_t)l * 3 + cond_of_row(m0)) * 6144;
    epi_residual(acc, p.out, p.out + (size_t)m0 * DM, mod + 5120, m0, n0);
  }
}

DI void phase_prologue(const Params& p, char* smem) {
  const int tid = tidx(), lane = tid & 63, wave = tid >> 6;
  for (int item = blockIdx.x; item < 384; item += gridDim.x) {
    {
      const int l = item / 96, cg = item % 96;
      float* sc = (float*)smem;
      float* red = sc + 3072;
      __syncthreads();
      for (int i = tid; i < 3072; i += 256) {
        const int c = i >> 10, k = i & 1023;
        const float v = (c == 0) ? p.c_ctx[k] : p.c[(c - 1) * 1024 + k];
        sc[i] = siluf_(v);
      }
      __syncthreads();
      const int cl = tid & 15, kg = tid >> 4;
      const float* w = p.w_ada + ((size_t)l * 1024 + kg * 64) * 6144 + cg * 64 + cl * 4;
      f32x4 a0 = {0, 0, 0, 0}, a1 = {0, 0, 0, 0}, a2 = {0, 0, 0, 0};
#pragma unroll 16
      for (int k = 0; k < 64; ++k) {
        const f32x4 wv = __builtin_nontemporal_load((const f32x4*)(w + (size_t)k * 6144));
        const float s0 = sc[kg * 64 + k], s1 = sc[1024 + kg * 64 + k], s2 = sc[2048 + kg * 64 + k];
#pragma unroll
        for (int e = 0; e < 4; ++e) { a0[e] += s0 * wv[e]; a1[e] += s1 * wv[e]; a2[e] += s2 * wv[e]; }
      }
      *(f32x4*)(red + (kg * 3 + 0) * 64 + cl * 4) = a0;
      *(f32x4*)(red + (kg * 3 + 1) * 64 + cl * 4) = a1;
      *(f32x4*)(red + (kg * 3 + 2) * 64 + cl * 4) = a2;
      __syncthreads();
      if (tid < 192) {
        const int c = tid >> 6, col = tid & 63;
        float s = 0.f;
#pragma unroll
        for (int g = 0; g < 16; ++g) s += red[(g * 3 + c) * 64 + col];
        const int cc = cg * 64 + col;
        p.mod[((size_t)l * 3 + c) * 6144 + cc] = s + p.b_ada[(size_t)l * 6144 + cc];
      }
    }
  }
  for (int i = blockIdx.x * 256 + tid; i < 2 * 4 * 256 * 128 / 8; i += gridDim.x * 256) {
    const f32x4 v0 = *(const f32x4*)(p.c_mla_ckv + (size_t)i * 8), v1 = *(const f32x4*)(p.c_mla_ckv + (size_t)i * 8 + 4);
    u32x4 o = {pk2(v0[0], v0[1]), pk2(v0[2], v0[3]), pk2(v1[0], v1[1]), pk2(v1[2], v1[3])};
    *(u32x4*)(p.cckv + (size_t)i * 8) = o;
  }
  {
    float* T = (float*)smem;
    for (int t = blockIdx.x; t < 4 * 4256; t += gridDim.x) {
      const int l = t / 4256; int r = t % 4256;
      const float* W; u16* D; int K, N, kt, nt;
      bool isin = false;
      if (r < 1616) { W = p.w_in + (size_t)l * DM * INC; D = p.Wt_in + (size_t)l * INP * DM; K = DM; N = INC; nt = r % 101; kt = r / 101; isin = true; }
      else if ((r -= 1616) < 1408) { W = p.w_up + (size_t)l * DM * UPC; D = p.Wt_up + (size_t)l * UPC * DM; K = DM; N = UPC; nt = r % 88; kt = r / 88; }
      else if ((r -= 1408) < 704) { W = p.w_down + (size_t)l * DFF * DM; D = p.Wt_down + (size_t)l * DM * DFF; K = DFF; N = DM; nt = r & 15; kt = r >> 4; }
      else if ((r -= 704) < 256) { W = p.w_out + (size_t)l * DM * DM; D = p.Wt_out + (size_t)l * DM * DM; K = DM; N = DM; nt = r & 15; kt = r >> 4; }
      else if ((r -= 256) < 256) { W = p.w_branch + (size_t)l * DM * DM; D = p.Wt_br + (size_t)l * DM * DM; K = DM; N = DM; nt = r & 15; kt = r >> 4; }
      else { r -= 256; W = p.w_ukv + (size_t)l * 128 * 512; D = p.Wt_ukv + (size_t)l * 512 * 128; K = 128; N = 512; nt = r & 7; kt = r >> 3; }
      const int k0 = kt * 64, n0 = nt * 64;
      __syncthreads();
      {
        const int c4 = (tid & 15) * 4, rr = tid >> 4;
        const bool ok = (n0 + c4) < N;
#pragma unroll
        for (int i = 0; i < 4; ++i) {
          f32x4 v = {0.f, 0.f, 0.f, 0.f};
          if (ok) v = __builtin_nontemporal_load((const f32x4*)(W + (size_t)(k0 + i * 16 + rr) * N + n0 + c4));
          float* tp = T + (i * 16 + rr) * 65 + c4;
          tp[0] = v[0]; tp[1] = v[1]; tp[2] = v[2]; tp[3] = v[3];
        }
      }
      __syncthreads();
      {
        const int kc = (tid & 7) * 8;
#pragma unroll
        for (int ps = 0; ps < 2; ++ps) {
          const int n = ps * 32 + (tid >> 3);
          if (n0 + n < N) {
            const float* tp = T + kc * 65 + n;
            u32x4 o = {pk2(tp[0], tp[65]), pk2(tp[2 * 65], tp[3 * 65]), pk2(tp[4 * 65], tp[5 * 65]), pk2(tp[6 * 65], tp[7 * 65])};
            const int drow = isin ? virt_col(n0 + n) : (n0 + n);
            *(u32x4*)(D + (size_t)drow * K + k0 + kc) = o;
          }
        }
      }
    }
  }
  const int gt = blockIdx.x * 256 + tid, gs = gridDim.x * 256;
  for (int it = gt; it < 2 * 65536 + 4 * 32768; it += gs) {
    const float* src; u16* dst; int H, i;
    if (it < 65536) { src = p.c_nat_k; dst = p.CKA; H = 4; i = it; }
    else if (it < 131072) { src = p.c_nat_v; dst = p.CVA; H = 4; i = it - 65536; }
    else {
      const int j = it - 131072; const int w = j >> 15; i = j & 32767; H = 2;
      src = (w == 0) ? p.c_gqa_k : (w == 1) ? p.c_gqa_v : (w == 2) ? p.c_win_k : p.c_win_v;
      dst = (w == 0) ? p.CKB : (w == 1) ? p.CVB : (w == 2) ? p.CKC : p.CVC;
    }
    const int d8 = i & 7, s = (i >> 3) & 255;
    int rest = i >> 11; const int h = rest % H; rest /= H; const int b = rest & 1, l = rest >> 1;
    const float* sp = src + (((size_t)(b * 4 + l) * 256 + s) * H + h) * 64 + d8 * 8;
    const f32x4 v0 = *(const f32x4*)sp, v1 = *(const f32x4*)(sp + 4);
    u32x4 o = {pk2(v0[0], v0[1]), pk2(v0[2], v0[3]), pk2(v1[0], v1[1]), pk2(v1[2], v1[3])};
    *(u32x4*)(dst + ((((size_t)(l * 2 + b) * H + h) * 256 + s) * 64 + d8 * 8)) = o;
  }
  for (int i = gt; i < 1536; i += gs) {
    if (i < 1024) {
      const int pos = i >> 4, f = i & 15;
      const float inv = exp2f(-13.287712379549449f * (float)(2 * f) / 32.f);
      const float ang = (float)pos * inv;
      p.tabs[i] = cosf(ang); p.tabs[1024 + i] = sinf(ang);
    } else {
      const int j = i - 1024; const int pos = j >> 3, f = j & 7;
      const float inv = exp2f(-13.287712379549449f * (float)(2 * f) / 16.f);
      const float ang = (float)pos * inv;
      p.tabs[2048 + j] = cosf(ang); p.tabs[2560 + j] = sinf(ang);
    }
  }
}

__global__ void __launch_bounds__(256, 2) mega_kernel(Params p, int ph_lo, int ph_hi) {
  __shared__ __attribute__((aligned(16))) char smem[SMEM_BYTES];
  __shared__ uint4 xb_words;
  __shared__ unsigned s_item_w[4];
  if (tidx() == 0) xb_words = make_uint4(0u, 0u, 0u, 0u);
  __syncthreads();
  XcdBarrier bar; bar.bar = p.ctrl; bar.x = 0; bar.st = (volatile LAS unsigned*)&xb_words;
  if (ph_hi - ph_lo > 1) bar = xcd_barrier_post(p.ctrl, (volatile LAS unsigned*)&xb_words);
  for (int ph = ph_lo; ph < ph_hi; ++ph) {
    if (ph == 0) phase_prologue(p, smem);
    else {
      const int l = (ph - 1) / 8, s = (ph - 1) % 8;
      switch (s) {
        case 0: phase_norm(p, l, 0); break;
        case 1: phase_g1(p, l, smem); break;
        case 2: phase_attn(p, l, smem, (LAS unsigned*)s_item_w); break;
        case 3: phase_merge(p, l, smem); break;
        case 4: phase_outproj(p, l, smem); break;
        case 5: phase_norm(p, l, 1); break;
        case 6: phase_up(p, l, smem); break;
        default: phase_down(p, l, smem); break;
      }
    }
    if (ph + 1 < ph_hi) xcd_barrier(bar);
  }
}

static inline size_t align_up(size_t x) { return (x + 255) & ~(size_t)255; }

extern "C" void kernel_launch(void* const* d_in, const int* in_sizes, int n_in, void* d_out, int out_size, void* d_ws, size_t ws_size,
                              hipStream_t stream) {
  Params p{};
  const float** fp = (const float**)&p;
  for (int i = 0; i < 35; ++i) fp[i] = (const float*)d_in[i];
  p.out = (float*)d_out;
  char* w = (char*)d_ws; size_t off = 0;
  auto take = [&](size_t bytes) { void* r = w + off; off = align_up(off + bytes); return r; };
  p.ctrl = (unsigned*)take(CTRL_WORDS * 4);
  p.mod = (float*)take((size_t)4 * 3 * 6144 * 4);
  p.tabs = (float*)take(3072 * 4);
  {
    void* ur = take((size_t)NTOK * UPC * 2);
    p.proj = (float*)ur; p.u = (u16*)ur; p.ub = (float*)ur;
  }
  p.gates = (u16*)take((size_t)NTOK * 4096 * 2);
  p.QA = (u16*)take((size_t)4 * NTOK * 64 * 2); p.KA = (u16*)take((size_t)4 * NTOK * 64 * 2); p.VA = (u16*)take((size_t)4 * NTOK * 64 * 2);
  p.QB = (u16*)take((size_t)4 * NTOK * 64 * 2); p.KB = (u16*)take((size_t)2 * NTOK * 64 * 2); p.VB = (u16*)take((size_t)2 * NTOK * 64 * 2);
  p.QC = (u16*)take((size_t)4 * NTOK * 64 * 2); p.KC = (u16*)take((size_t)2 * NTOK * 64 * 2); p.VC = (u16*)take((size_t)2 * NTOK * 64 * 2);
  p.QD = (u16*)take((size_t)4 * NTOK * 96 * 2); p.KD = (u16*)take((size_t)4 * NTOK * 96 * 2); p.VD = (u16*)take((size_t)4 * NTOK * 64 * 2);
  p.act = p.QA;
  p.ckvn = (u16*)take((size_t)NTOK * 128 * 2);
  p.br = (u16*)take((size_t)NTOK * 1024 * 2);
  p.merged = (u16*)take((size_t)NTOK * 1024 * 2);
  p.h = p.merged;
  p.CKA = (u16*)take((size_t)4 * 2 * 4 * 256 * 64 * 2); p.CVA = (u16*)take((size_t)4 * 2 * 4 * 256 * 64 * 2);
  p.CKB = (u16*)take((size_t)4 * 2 * 2 * 256 * 64 * 2); p.CVB = (u16*)take((size_t)4 * 2 * 2 * 256 * 64 * 2);
  p.CKC = (u16*)take((size_t)4 * 2 * 2 * 256 * 64 * 2); p.CVC = (u16*)take((size_t)4 * 2 * 2 * 256 * 64 * 2);
  p.CKD = (u16*)take((size_t)4 * 2 * 4 * 256 * 96 * 2); p.CVD = (u16*)take((size_t)4 * 2 * 4 * 256 * 64 * 2);
  p.cckv = (u16*)take((size_t)2 * 4 * 256 * 128 * 2);
  p.kpe = (float*)take((size_t)NTOK * 32 * 4);
  p.Wt_in = (u16*)take((size_t)4 * INP * DM * 2);
  p.Wt_up = (u16*)take((size_t)4 * UPC * DM * 2);
  p.Wt_down = (u16*)take((size_t)4 * DM * DFF * 2);
  p.Wt_out = (u16*)take((size_t)4 * DM * DM * 2);
  p.Wt_br = (u16*)take((size_t)4 * DM * DM * 2);
  p.Wt_ukv = (u16*)take((size_t)4 * 512 * 128 * 2);
  if (off > ws_size) fprintf(stderr, "workspace too small: need %zu have %zu\n", off, ws_size);

  static int grid_blocks = 0;
  if (!grid_blocks) {
    int dev = 0, cus = 0, per_cu = 0;
    hipGetDevice(&dev);
    hipDeviceGetAttribute(&cus, hipDeviceAttributeMultiprocessorCount, dev);
    hipOccupancyMaxActiveBlocksPerMultiprocessor(&per_cu, mega_kernel, 256, 0);
    if (per_cu > 2) per_cu = 2;
    if (per_cu < 1) per_cu = 1;
    grid_blocks = cus * per_cu;
  }
  hipMemsetAsync(p.ctrl, 0, CTRL_WORDS * 4, stream);
#if SINGLE_LAUNCH
  int lo = 0, hi = NPHASE;
  void* args[] = {&p, &lo, &hi};
  hipError_t e = hipLaunchCooperativeKernel((void*)mega_kernel, dim3(grid_blocks), dim3(256), args, 0, stream);
  if (e != hipSuccess) fprintf(stderr, "cooperative launch failed: %s (grid %d)\n", hipGetErrorString(e), grid_blocks);
#else
  for (int ph = 0; ph < NPHASE; ++ph) mega_kernel<<<grid_blocks, 256, 0, stream>>>(p, ph, ph + 1);
#endif
}
```
